# Optimizing an MI355X kernel written in HIP

```python
import math
import jax, jax.numpy as jnp
from jax import lax
import numpy as np

D_MODEL = 1024
BATCH = 2
SEQ = 16384
DEPTH = 4

HEAD_DIM = 64
BLK = 128
NEG_INF = -1e30
REL_BUCKETS = 32
REL_MAX_DIST = 2048
A_HEADS = 8
A_KV_HEADS = 2
A_WINDOW = 128
B_HEADS = 8
B_PATTERNS = ((128, 1), (512, 4), (2048, 16))
C_HEADS = 4
C_QK_DIM = 256
C_V_DIM = 512
C_CHUNK = 128
D_HEADS = 16
D_KV_HEADS = 2
D_CMP_LEN = 32
D_CMP_STRIDE = 16
D_CMP_HIDDEN = 128
D_SEL_LEN = 64
D_SEL_COUNT = 16
D_WINDOW = 512
D_FF = -(-8 * D_MODEL // (3 * 256)) * 256

N_BIAS_HEADS = A_HEADS + B_HEADS
A_Q = A_HEADS * HEAD_DIM
A_KV = A_KV_HEADS * HEAD_DIM
B_W = B_HEADS * HEAD_DIM
EVEN_SIZES = (A_Q, A_KV, A_KV, B_W, B_W, B_W)
EVEN_IN = sum(EVEN_SIZES)
EVEN_OUT = A_Q + B_W
C_QK = C_HEADS * C_QK_DIM
C_V = C_HEADS * C_V_DIM
D_Q = D_HEADS * HEAD_DIM
D_KV = D_KV_HEADS * HEAD_DIM
ODD_SIZES = (C_QK, C_QK, C_V, C_V, D_Q, D_KV, D_KV, D_KV, D_KV, D_KV, D_KV, 3 * D_HEADS)
ODD_IN = sum(ODD_SIZES)
ODD_OUT = C_V + D_Q

kernel_name = "hybrid_swa_dilated_retention_nsa_trunk"


def split_cols(x, sizes):
    idx = [int(i) for i in np.cumsum(sizes)[:-1]]
    return jnp.split(x, idx, axis=-1)


def rms_norm(x, w, eps=1e-6):
    xf = x.astype(jnp.float32)
    y = xf * lax.rsqrt(jnp.mean(xf * xf, axis=-1, keepdims=True) + eps)
    return (y * w.astype(jnp.float32)).astype(x.dtype)


def t5_bucket(dist):
    max_exact = REL_BUCKETS // 2
    d = jnp.maximum(dist, 0)
    df = jnp.maximum(d, 1).astype(jnp.float32)
    large = max_exact + (jnp.log(df / max_exact) / math.log(REL_MAX_DIST / max_exact)
                         * (REL_BUCKETS - max_exact)).astype(jnp.int32)
    large = jnp.minimum(large, REL_BUCKETS - 1)
    return jnp.where(d < max_exact, d, large)


def masked_softmax(s, mask):
    s = jnp.where(mask, s, NEG_INF)
    m = jnp.max(s, axis=-1, keepdims=True)
    p = jnp.where(mask, jnp.exp(s - m), 0.0)
    return p / jnp.maximum(jnp.sum(p, axis=-1, keepdims=True), 1e-30)


def banded_attention(q, k, v, max_dist, dist_scale, bias_table, sinks=None):
    B, L, H, D = q.shape
    G = k.shape[2]
    hpg = H // G
    nb = -(-max_dist // BLK)
    n_blk = -(-L // BLK)
    Lp = n_blk * BLK
    qp = jnp.pad(q, ((0, 0), (0, Lp - L), (0, 0), (0, 0)))
    kp = jnp.pad(k, ((0, 0), (nb * BLK, Lp - L), (0, 0), (0, 0)))
    vp = jnp.pad(v, ((0, 0), (nb * BLK, Lp - L), (0, 0), (0, 0)))
    kw = (nb + 1) * BLK
    rel = jnp.arange(BLK)[:, None] + nb * BLK - jnp.arange(kw)[None, :]
    band = (rel >= 0) & (rel <= max_dist)
    bias = jnp.transpose(bias_table.astype(jnp.float32)[t5_bucket(rel * dist_scale)], (2, 0, 1))
    bias = bias.reshape(G, hpg, BLK, kw)
    scale = D ** -0.5

    def one_block(i):
        qb = lax.dynamic_slice_in_dim(qp, i * BLK, BLK, axis=1).reshape(B, BLK, G, hpg, D)
        kb = lax.dynamic_slice_in_dim(kp, i * BLK, kw, axis=1)
        vb = lax.dynamic_slice_in_dim(vp, i * BLK, kw, axis=1)
        s = jnp.einsum('btghd,bsgd->bghts', qb, kb).astype(jnp.float32) * scale + bias
        kpos = i * BLK - nb * BLK + jnp.arange(kw)
        mask = band & (kpos >= 0)[None, :]
        s = jnp.where(mask, s, NEG_INF)
        m = jnp.max(s, axis=-1, keepdims=True)
        if sinks is not None:
            sk = sinks.astype(jnp.float32).reshape(1, G, hpg, 1, 1)
            m = jnp.maximum(m, sk)
        p = jnp.exp(s - m)
        denom = jnp.sum(p, axis=-1, keepdims=True)
        if sinks is not None:
            denom = denom + jnp.exp(sk - m)
        o = jnp.einsum('bghts,bsgd->btghd', (p / denom).astype(v.dtype), vb)
        lse = (m + jnp.log(denom))[..., 0]
        return o.reshape(B, BLK, H, D), jnp.transpose(lse, (0, 3, 1, 2)).reshape(B, BLK, H)

    o, lse = lax.map(one_block, jnp.arange(n_blk))
    o = jnp.transpose(o, (1, 0, 2, 3, 4)).reshape(B, Lp, H, D)[:, :L]
    lse = jnp.transpose(lse, (1, 0, 2, 3)).reshape(B, Lp, H)[:, :L]
    return o, lse


def dilated_attention(q, k, v, bias_table):
    B, S, H, D = q.shape
    outs, lses = [], []
    for window, dil in B_PATTERNS:
        L = S // dil

        def to_sub(a):
            return jnp.transpose(a.reshape(B, L, dil, H, D), (0, 2, 1, 3, 4)).reshape(B * dil, L, H, D)

        o, lse = banded_attention(to_sub(q), to_sub(k), to_sub(v), window // dil, dil, bias_table)
        outs.append(jnp.transpose(o.reshape(B, dil, L, H, D), (0, 2, 1, 3, 4)).reshape(B, S, H, D))
        lses.append(jnp.transpose(lse.reshape(B, dil, L, H), (0, 2, 1, 3)).reshape(B, S, H))
    w = jax.nn.softmax(jnp.stack(lses, axis=0), axis=0)
    out = jnp.einsum('pbsh,pbshd->bshd', w, jnp.stack(outs, axis=0).astype(jnp.float32))
    return out.astype(q.dtype)


def rotary(x, pos):
    d = x.shape[-1]
    inv = 1.0 / (10000.0 ** (jnp.arange(0, d, 2, dtype=jnp.float32) / d))
    ang = pos.astype(jnp.float32)[:, None] * inv[None, :]
    cos = jnp.cos(ang)[:, None, :]
    sin = jnp.sin(ang)[:, None, :]
    x1, x2 = jnp.split(x, 2, axis=-1)
    return jnp.concatenate([x1 * cos - x2 * sin, x1 * sin + x2 * cos], axis=-1)


def retention(q, k, v):
    B, S, H, dk = q.shape
    dv = v.shape[-1]
    pos = jnp.arange(S)
    q = rotary(q, pos)
    k = rotary(k, pos) * dk ** -0.5
    log_g = jnp.log(1.0 - 2.0 ** (-5.0 - jnp.arange(H, dtype=jnp.float32)))
    C = C_CHUNK
    nC = S // C
    j = jnp.arange(C, dtype=jnp.float32)
    diff = j[:, None] - j[None, :]
    dmask = jnp.where(diff >= 0, jnp.exp(diff[None] * log_g[:, None, None]), 0.0)
    q_dec = jnp.exp((j[None, :] + 1.0) * log_g[:, None])[None, :, :, None]
    k_dec = jnp.exp((C - 1.0 - j[None, :]) * log_g[:, None])[None, :, :, None]
    chunk_dec = jnp.exp(C * log_g)[None, :, None, None]

    def chunks(a):
        return jnp.transpose(a.reshape(B, nC, C, H, a.shape[-1]), (1, 0, 3, 2, 4))

    def step(R, xs):
        qc, kc, vc = xs
        inner = jnp.einsum('bhid,bhjd->bhij', qc, kc) * dmask
        o = jnp.einsum('bhij,bhjv->bhiv', inner, vc) + jnp.einsum('bhid,bhdv->bhiv', qc, R) * q_dec
        R = R * chunk_dec + jnp.einsum('bhjd,bhjv->bhdv', kc * k_dec, vc)
        return R, o

    R0 = jnp.zeros((B, H, dk, dv), jnp.float32)
    _, o = lax.scan(step, R0, (chunks(q), chunks(k), chunks(v)))
    return jnp.transpose(o, (1, 0, 3, 2, 4)).reshape(B, S, H, dv)


def nsa_attention(q, k_cmp, v_cmp, k_slc, v_slc, k_win, v_win, gate_logits,
                  pos_k, pos_v, k_w1, k_w2, v_w1, v_w2, rel_table):
    B, S, H, D = q.shape
    G = k_cmp.shape[2]
    hpg = H // G
    rc = D_CMP_LEN // D_CMP_STRIDE
    rs = D_SEL_LEN // D_CMP_STRIDE
    n_cmp = S // D_CMP_STRIDE - (rc - 1)

    def compress(a, pos, w1, w2):
        xs = a.reshape(B, S // D_CMP_STRIDE, D_CMP_STRIDE, G, D)
        blocks = jnp.concatenate([xs[:, j:j + n_cmp] for j in range(rc)], axis=2)
        blocks = blocks + pos[None, None, :, None, :].astype(a.dtype)
        flat = jnp.transpose(blocks, (0, 1, 3, 2, 4)).reshape(B, n_cmp, G, D_CMP_LEN * D)
        return jax.nn.gelu(flat @ w1) @ w2

    kc = compress(k_cmp, pos_k, k_w1, k_w2)
    vc = compress(v_cmp, pos_v, v_w1, v_w2)
    cmp_end = jnp.arange(n_cmp) * D_CMP_STRIDE + D_CMP_LEN - 1
    n_sb = S // D_SEL_LEN
    n_sel = min(D_SEL_COUNT, n_sb)
    k_blk = jnp.transpose(k_slc.reshape(B, n_sb, D_SEL_LEN, G, D), (0, 3, 1, 2, 4))
    v_blk = jnp.transpose(v_slc.reshape(B, n_sb, D_SEL_LEN, G, D), (0, 3, 1, 2, 4))
    table = rel_table.astype(jnp.float32)
    table_g = jnp.transpose(table.reshape(REL_BUCKETS, G, hpg), (1, 0, 2))
    gidx = jnp.arange(G)[None, :, None, None, None]
    scale = D ** -0.5
    gather = jax.vmap(jax.vmap(lambda kb, ix: kb[ix]))

    def one_block(i):
        t = i * BLK + jnp.arange(BLK)
        qb = lax.dynamic_slice_in_dim(q, i * BLK, BLK, axis=1).reshape(B, BLK, G, hpg, D)
        bias_c = jnp.transpose(table[t5_bucket(t[:, None] - cmp_end[None, :])], (2, 0, 1))
        bias_c = bias_c.reshape(G, hpg, BLK, n_cmp)
        s_c = jnp.einsum('btghd,bngd->bghtn', qb, kc).astype(jnp.float32) * scale + bias_c
        p_c = masked_softmax(s_c, cmp_end[None, :] <= t[:, None])
        o_c = jnp.einsum('bghtn,bngd->btghd', p_c.astype(vc.dtype), vc)
        imp = jnp.pad(p_c.sum(axis=2), ((0, 0), (0, 0), (0, 0), (rc - 1, rc - 1)))
        imp_sel = sum(imp[..., u:u + rs * (n_sb - 1) + 1:rs] for u in range(rs + rc - 1))
        cur = t // D_SEL_LEN
        jb = jnp.arange(n_sb)[None, :]
        forced = (jb == 0) | (jb == cur[:, None]) | (jb == cur[:, None] - 1)
        valid = jb <= cur[:, None]
        score = jnp.where(forced, 1e9, jnp.where(valid, imp_sel, -1e9))
        _, idx = lax.top_k(score, n_sel)
        ks = gather(k_blk, idx)
        vs = gather(v_blk, idx)
        kpos = idx[..., None] * D_SEL_LEN + jnp.arange(D_SEL_LEN)
        dist = t[None, None, :, None, None] - kpos
        bias_s = jnp.moveaxis(table_g[gidx, t5_bucket(dist)], -1, 2)
        s_s = jnp.einsum('btghd,bgtnld->bghtnl', qb, ks).astype(jnp.float32) * scale + bias_s
        nl = n_sel * D_SEL_LEN
        p_s = masked_softmax(s_s.reshape(B, G, hpg, BLK, nl),
                             (dist >= 0).reshape(B, G, 1, BLK, nl)).reshape(s_s.shape)
        o_s = jnp.einsum('bghtnl,bgtnld->btghd', p_s.astype(vs.dtype), vs)
        return o_c.reshape(B, BLK, H, D), o_s.reshape(B, BLK, H, D)

    o_c, o_s = lax.map(one_block, jnp.arange(S // BLK))
    o_c = jnp.transpose(o_c, (1, 0, 2, 3, 4)).reshape(B, S, H, D)
    o_s = jnp.transpose(o_s, (1, 0, 2, 3, 4)).reshape(B, S, H, D)
    o_w, _ = banded_attention(q, k_win, v_win, D_WINDOW - 1, 1, rel_table)
    g = jax.nn.sigmoid(gate_logits.astype(jnp.float32))
    out = g[..., 0:1] * o_c + g[..., 1:2] * o_s + g[..., 2:3] * o_w
    return out.astype(q.dtype)


def even_mixer(h, w_in, sinks, w_out, rel_table):
    B, S, _ = h.shape
    qa, ka, va, qb, kb, vb = split_cols(h @ w_in, EVEN_SIZES)
    qa = qa.reshape(B, S, A_HEADS, HEAD_DIM)
    ka = ka.reshape(B, S, A_KV_HEADS, HEAD_DIM)
    va = va.reshape(B, S, A_KV_HEADS, HEAD_DIM)
    oa, _ = banded_attention(qa, ka, va, A_WINDOW - 1, 1, rel_table[:, :A_HEADS], sinks)
    qb = qb.reshape(B, S, B_HEADS, HEAD_DIM)
    kb = kb.reshape(B, S, B_HEADS, HEAD_DIM)
    vb = vb.reshape(B, S, B_HEADS, HEAD_DIM)
    ob = dilated_attention(qb, kb, vb, rel_table[:, A_HEADS:A_HEADS + B_HEADS])
    o = jnp.concatenate([oa.reshape(B, S, A_Q), ob.reshape(B, S, B_W)], axis=-1)
    return o @ w_out


def odd_mixer(h, w_in, ret_gn, cmp_pos_k, cmp_pos_v, cmp_k_w1, cmp_k_w2, cmp_v_w1, cmp_v_w2,
              w_out, rel_table):
    B, S, _ = h.shape
    (qc, kc, vc, gc, qd, k_cmp, v_cmp, k_slc, v_slc, k_win, v_win, gd) = split_cols(h @ w_in, ODD_SIZES)
    oc = retention(qc.reshape(B, S, C_HEADS, C_QK_DIM).astype(jnp.float32),
                   kc.reshape(B, S, C_HEADS, C_QK_DIM).astype(jnp.float32),
                   vc.reshape(B, S, C_HEADS, C_V_DIM).astype(jnp.float32))
    mu = jnp.mean(oc, axis=-1, keepdims=True)
    var = jnp.mean(jnp.square(oc - mu), axis=-1, keepdims=True)
    oc = ((oc - mu) * lax.rsqrt(var + 1e-5)).reshape(B, S, C_V)
    oc = (oc * ret_gn.astype(jnp.float32) * jax.nn.silu(gc.astype(jnp.float32))).astype(h.dtype)
    kv = lambda a: a.reshape(B, S, D_KV_HEADS, HEAD_DIM)
    od = nsa_attention(qd.reshape(B, S, D_HEADS, HEAD_DIM), kv(k_cmp), kv(v_cmp), kv(k_slc), kv(v_slc),
                       kv(k_win), kv(v_win), gd.reshape(B, S, D_HEADS, 3),
                       cmp_pos_k, cmp_pos_v, cmp_k_w1, cmp_k_w2, cmp_v_w1, cmp_v_w2, rel_table)
    o = jnp.concatenate([oc, od.reshape(B, S, D_Q)], axis=-1)
    return o @ w_out


def swiglu(h, w_gate, w_up, w_down):
    return (jax.nn.silu(h @ w_gate) * (h @ w_up)) @ w_down


def setup_inputs(seed: int = 0) -> dict:
    key = jax.random.key(seed)
    ks = jax.random.split(key, 24)
    n_even = (DEPTH + 1) // 2
    n_odd = DEPTH // 2

    def nrm(k, shape, scale):
        return jax.random.normal(k, shape, jnp.float32) * scale

    return {
        "x": nrm(ks[0], (BATCH, SEQ, D_MODEL), 1.0),
        "rel_table": nrm(ks[1], (REL_BUCKETS, N_BIAS_HEADS), 0.5),
        "norm_mix": 1.0 + nrm(ks[2], (DEPTH, D_MODEL), 0.02),
        "norm_ffn": 1.0 + nrm(ks[3], (DEPTH, D_MODEL), 0.02),
        "norm_final": 1.0 + nrm(ks[4], (D_MODEL,), 0.02),
        "even_w_in": nrm(ks[5], (n_even, D_MODEL, EVEN_IN), D_MODEL ** -0.5),
        "even_sinks": nrm(ks[6], (n_even, A_HEADS), 0.5),
        "even_w_out": nrm(ks[7], (n_even, EVEN_OUT, D_MODEL), EVEN_OUT ** -0.5),
        "odd_w_in": nrm(ks[8], (n_odd, D_MODEL, ODD_IN), D_MODEL ** -0.5),
        "odd_ret_gn": 1.0 + nrm(ks[9], (n_odd, C_V), 0.02),
        "odd_cmp_pos_k": nrm(ks[10], (n_odd, D_CMP_LEN, HEAD_DIM), 0.1),
        "odd_cmp_pos_v": nrm(ks[11], (n_odd, D_CMP_LEN, HEAD_DIM), 0.1),
        "odd_cmp_k_w1": nrm(ks[12], (n_odd, D_CMP_LEN * HEAD_DIM, D_CMP_HIDDEN), (D_CMP_LEN * HEAD_DIM) ** -0.5),
        "odd_cmp_k_w2": nrm(ks[13], (n_odd, D_CMP_HIDDEN, HEAD_DIM), D_CMP_HIDDEN ** -0.5),
        "odd_cmp_v_w1": nrm(ks[14], (n_odd, D_CMP_LEN * HEAD_DIM, D_CMP_HIDDEN), (D_CMP_LEN * HEAD_DIM) ** -0.5),
        "odd_cmp_v_w2": nrm(ks[15], (n_odd, D_CMP_HIDDEN, HEAD_DIM), D_CMP_HIDDEN ** -0.5),
        "odd_w_out": nrm(ks[16], (n_odd, ODD_OUT, D_MODEL), ODD_OUT ** -0.5),
        "ffn_w_gate": nrm(ks[17], (DEPTH, D_MODEL, D_FF), D_MODEL ** -0.5),
        "ffn_w_up": nrm(ks[18], (DEPTH, D_MODEL, D_FF), D_MODEL ** -0.5),
        "ffn_w_down": nrm(ks[19], (DEPTH, D_FF, D_MODEL), D_FF ** -0.5),
    }


def reference(x, rel_table, norm_mix, norm_ffn, norm_final, even_w_in, even_sinks, even_w_out,
              odd_w_in, odd_ret_gn, odd_cmp_pos_k, odd_cmp_pos_v, odd_cmp_k_w1, odd_cmp_k_w2,
              odd_cmp_v_w1, odd_cmp_v_w2, odd_w_out, ffn_w_gate, ffn_w_up, ffn_w_down):
    h = x
    for layer in range(DEPTH):
        hn = rms_norm(h, norm_mix[layer])
        li = layer // 2
        if layer % 2 == 0:
            h = h + even_mixer(hn, even_w_in[li], even_sinks[li], even_w_out[li], rel_table)
        else:
            h = h + odd_mixer(hn, odd_w_in[li], odd_ret_gn[li], odd_cmp_pos_k[li], odd_cmp_pos_v[li],
                              odd_cmp_k_w1[li], odd_cmp_k_w2[li], odd_cmp_v_w1[li], odd_cmp_v_w2[li],
                              odd_w_out[li], rel_table)
        h = h + swiglu(rms_norm(h, norm_ffn[layer]), ffn_w_gate[layer], ffn_w_up[layer], ffn_w_down[layer])
    return rms_norm(h, norm_final)
```

```cpp
#include <hip/hip_runtime.h>
#include <hip/hip_cooperative_groups.h>
#include <cstdio>
#include <cstdint>
namespace cg = cooperative_groups;

#define LAS __attribute__((address_space(3)))
typedef unsigned short bf16_t;
typedef short bf16x8 __attribute__((ext_vector_type(8)));
typedef float f32x4 __attribute__((ext_vector_type(4)));
typedef unsigned u32x4 __attribute__((ext_vector_type(4)));
typedef unsigned u32x2 __attribute__((ext_vector_type(2)));

__device__ __forceinline__ unsigned f2bf(float f) { unsigned u = __builtin_bit_cast(unsigned, f); return (u + 0x7fffu + ((u >> 16) & 1u)) >> 16; }
__device__ __forceinline__ unsigned pk2s(float lo, float hi) { return f2bf(lo) | (f2bf(hi) << 16); }
typedef float f32x2_t __attribute__((ext_vector_type(2)));
typedef __bf16 bf16x2_t __attribute__((ext_vector_type(2)));
__device__ __forceinline__ unsigned pk2(float lo, float hi) { f32x2_t v = {lo, hi}; bf16x2_t b = __builtin_convertvector(v, bf16x2_t); return __builtin_bit_cast(unsigned, b); }
__device__ __forceinline__ float bf2f(bf16_t b) { return __builtin_bit_cast(float, (unsigned)b << 16); }
__device__ __forceinline__ float bflo(unsigned w) { return __builtin_bit_cast(float, w << 16); }
__device__ __forceinline__ float bfhi(unsigned w) { return __builtin_bit_cast(float, w & 0xffff0000u); }
__device__ __forceinline__ f32x4 mfma16(bf16x8 a, bf16x8 b, f32x4 c) { return __builtin_amdgcn_mfma_f32_16x16x32_bf16(a, b, c, 0, 0, 0); }
__device__ __forceinline__ bf16x8 mk8(u32x2 lo, u32x2 hi) { u32x4 v = {lo.x, lo.y, hi.x, hi.y}; return __builtin_bit_cast(bf16x8, v); }
__device__ __forceinline__ bf16x8 mk8p(float a0, float a1, float a2, float a3, float b0, float b1, float b2, float b3) {
    u32x4 v = {pk2(a0, a1), pk2(a2, a3), pk2(b0, b1), pk2(b2, b3)}; return __builtin_bit_cast(bf16x8, v); }
__device__ __forceinline__ float shx(float v, int mask, int lane) { return __builtin_bit_cast(float, __builtin_amdgcn_ds_bpermute((lane ^ mask) << 2, __builtin_bit_cast(int, v))); }
__device__ __forceinline__ int shx(int v, int mask, int lane) { return __builtin_amdgcn_ds_bpermute((lane ^ mask) << 2, v); }
__device__ __forceinline__ float sigmoidf_(float x) { return 1.0f / (1.0f + __expf(-x)); }
__device__ __forceinline__ float siluf_(float x) { return x / (1.0f + __expf(-x)); }
__device__ __forceinline__ int t5b(int d) {
    float f = __log2f((float)d * 0.0625f) * 2.2857144f;
    int k = (int)f; k = k > 15 ? 15 : k;
    return d < 16 ? d : 16 + k;
}

__device__ __forceinline__ int launder_tid() { int t = threadIdx.x; asm volatile("" : "+v"(t)); return t; }
__device__ __forceinline__ unsigned char* launder_ptr(unsigned char* q) { asm volatile("" : "+s"(q)); return q; }
__device__ __forceinline__ int launder_bid() { int t = blockIdx.x; asm volatile("" : "+s"(t)); return t; }
__device__ __forceinline__ int tperm(int tt) { return ((tt & 12) << 1) | ((tt >> 4) << 2) | (tt & 3); }
__device__ __forceinline__ size_t tb_off(int ndim, int dim, int t) { return ((size_t)(t >> 5) * ndim + dim) * 32 + tperm(t & 31); }
__device__ __forceinline__ size_t rb_off(int nks, int t, int col) { return (((size_t)(t >> 4) * nks + (col >> 5)) * 16 + (t & 15)) * 32 + (col & 31); }
constexpr int S_ = 16384, NB_ = 2, M_ = S_ * NB_, DM = 1024, FF_ = 2816;
constexpr size_t MiB = 1u << 20;
constexpr size_t WS_SMALL = 0;
constexpr size_t WS_WIN = 1 * MiB, WS_WOUT = 17 * MiB, WS_WGU = 23 * MiB, WS_WDN = 34 * MiB, WS_WC1 = 40 * MiB, WS_WC2 = 41 * MiB;
constexpr size_t WS_HN = 45 * MiB, WS_O = 109 * MiB, WS_BIG = 205 * MiB, WS_MISC = 487 * MiB, WS_END = 490 * MiB;
constexpr size_t OB_QT = 0, OB_KT = 32 * MiB, OB_KTT = 64 * MiB, OB_VTT = 96 * MiB, OB_GC = 160 * MiB, OB_QD = 224 * MiB, OB_KCMP = 256 * MiB, OB_VCMP = 260 * MiB,
                 OB_KSLC = 264 * MiB, OB_VSLCT = 268 * MiB, OB_KWIN = 272 * MiB, OB_VWIN = 276 * MiB, OB_GD = 280 * MiB;
constexpr size_t EB_QKV = 0, EB_OP = 144 * MiB, EB_LSE = 240 * MiB;
constexpr size_t MS_KC = 0, MS_VCT = 256 * 1024, MS_IDX = 1 * MiB;
constexpr int LDS_TBL = 132096;
constexpr int LDS_XB = 134144;
constexpr size_t WS_BAR = 65536;
constexpr int LDS_BYTES = 143360;

struct Params {
    const float* x; const float* rel_table; const float* norm_mix; const float* norm_ffn; const float* norm_final;
    const float* even_w_in; const float* even_sinks; const float* even_w_out;
    const float* odd_w_in; const float* odd_ret_gn; const float* odd_cmp_pos_k; const float* odd_cmp_pos_v;
    const float* odd_cmp_k_w1; const float* odd_cmp_k_w2; const float* odd_cmp_v_w1; const float* odd_cmp_v_w2; const float* odd_w_out;
    const float* ffn_w_gate; const float* ffn_w_up; const float* ffn_w_down;
    float* out; unsigned char* ws;
    int ph_lo, ph_hi;
};

namespace pg8 {
#define PG8_LAS __attribute__((address_space(3)))
constexpr int BM = 256, BK = 64, HALF = 128, HTB = HALF * BK * 2  , STAGE_BYTES = 8 * HTB, NXCD = 8, WGM = 8;
__host__ __device__ __forceinline__ int lds_byte(int r, int c) { const int st = (r >> 4) * 2 + (c >> 5), rr = r & 15, cc = c & 31, ob = rr * 64 + cc * 2; return st * 1024 + (ob ^ (((ob >> 9) & 1) << 5)); }
__host__ __device__ __forceinline__ void stage_rc(int b, int& R, int& C) { const int st = b / 1024, sb = b % 1024, swz = sb ^ (((sb >> 9) & 1) << 5); R = (st >> 1) * 16 + swz / 64; C = (st & 1) * 32 + (swz % 64) / 2; }
__host__ __device__ __forceinline__ int perm32(int rho) { const int n = rho >> 4, i = rho & 15; return 8 * (i >> 2) + 4 * n + (i & 3); }

struct Unit { int pm, pn; };
struct Gemm { const bf16_t* A; const bf16_t* Bt; int M, N, K; };

struct StaticOrder {
    int nM, nN, nwg, G, c;
    __host__ __device__ void init(int M, int N, int G_, int c_) { nM = M / BM; nN = N / BM; nwg = nM * nN; G = G_; c = c_; }
    __host__ __device__ bool next(int i, Unit& u) const {
        const long L = (long)i * G + c; if (L >= nwg) return false;
        int wgid = (int)L; { const int q = nwg / NXCD, r = nwg % NXCD, xcd = wgid % NXCD, off = wgid / NXCD; wgid = (xcd < r ? xcd * (q + 1) : r * (q + 1) + (xcd - r) * q) + off; }
        const int nig = WGM * nN, gid = wgid / nig, fm = gid * WGM, gsz = (nM - fm) < WGM ? (nM - fm) : WGM;
        u.pm = fm + ((wgid % nig) % gsz); u.pn = (wgid % nig) / gsz; return true;
    }
    __device__ __forceinline__ void a_ready(const Unit&) const {}
    __device__ __forceinline__ void done(const Unit&) const {}
};

__device__ __forceinline__ unsigned cvt_pk_bf16(float lo, float hi) { unsigned r; asm volatile("v_cvt_pk_bf16_f32 %0, %1, %2" : "=v"(r) : "v"(lo), "v"(hi)); return r; }
template <class Epi, class Sched, bool ALIGN_EPI = false, bool SP2 = false>
__device__ __forceinline__ void gemm_phase(PG8_LAS unsigned char* lds, const Gemm g, const Sched& S, const Epi& E) {
    const int tid = launder_tid(), wid = __builtin_amdgcn_readfirstlane(tid >> 6), lane = tid & 63, wr = wid >> 2, wc = wid & 3, fr = lane & 15, fq = lane >> 4;
    const int K = g.K, nt = K / BK;
    unsigned voffA[2], voffB[2];
#pragma unroll
    for (int i = 0; i < 2; ++i) { int R, C; stage_rc(tid * 16 + i * 8192, R, C); const int Rb = Epi::PERM ? ((R & ~31) + perm32(R & 31)) : R;
        voffA[i] = (unsigned)(R * K + C) * 2u; voffB[i] = (unsigned)(Rb * K + C) * 2u; }
    const size_t kstep = (size_t)(BK * 2);
    const size_t hstep = (size_t)HALF * K * 2;
    const size_t tstep = 2 * hstep;
    const unsigned ldsw = (unsigned)wid * 1024u;
    const int aoff = lds_byte(wr * 64 + fr, fq * 8), boff = lds_byte(wc * 32 + fr, fq * 8);
#define PG8_SA(b, h) (((b) * 2 + (h)) * HTB)
#define PG8_SB(b, h) ((4 + (b) * 2 + (h)) * HTB)
#define PG8_STAGE(bufoff, gbase, voff) do { _Pragma("unroll") for (int _i = 0; _i < 2; ++_i) \
        __builtin_amdgcn_global_load_lds((const unsigned*)((const char*)(gbase) + (voff)[_i]), (PG8_LAS unsigned*)(lds + (bufoff) + ldsw + _i * 8192), 16, 0, 0); } while (0)
#define PG8_LDA(dst, b, h) do { _Pragma("unroll") for (int m = 0; m < 4; ++m) _Pragma("unroll") for (int k = 0; k < 2; ++k) dst[m][k] = *(const PG8_LAS bf16x8*)(lds + PG8_SA(b, h) + aoff + m * 2048 + k * 1024); } while (0)
#define PG8_LDB(dst, b, h) do { _Pragma("unroll") for (int n = 0; n < 2; ++n) _Pragma("unroll") for (int k = 0; k < 2; ++k) dst[n][k] = *(const PG8_LAS bf16x8*)(lds + PG8_SB(b, h) + boff + n * 2048 + k * 1024); } while (0)
#define PG8_MMA(ai, bj, At, Bt) do { __builtin_amdgcn_s_setprio(1); _Pragma("unroll") for (int m = 0; m < 4; ++m) _Pragma("unroll") for (int n = 0; n < 2; ++n) _Pragma("unroll") for (int k = 0; k < 2; ++k) \
        acc[ai][bj][m][n] = __builtin_amdgcn_mfma_f32_16x16x32_bf16(Bt[n][k], At[m][k], acc[ai][bj][m][n], 0, 0, 0); __builtin_amdgcn_s_setprio(0); } while (0)
#define PG8_WAIT_V(n) asm volatile("s_waitcnt vmcnt(" #n ")" ::: "memory")
#define PG8_WAIT_L(n) asm volatile("s_waitcnt lgkmcnt(" #n ")" ::: "memory")
#define PG8_BAR __builtin_amdgcn_s_barrier()
#define PG8_SCHED __builtin_amdgcn_sched_barrier(0)
    Unit cur, nxt; int ui = 0;
    if (!S.next(0, cur)) return;
    f32x4 acc[2][2][4][2];
#pragma unroll
    for (int a = 0; a < 2; ++a)
#pragma unroll
        for (int b = 0; b < 2; ++b)
#pragma unroll
            for (int m = 0; m < 4; ++m)
#pragma unroll
                for (int n = 0; n < 2; ++n) acc[a][b][m][n] = (f32x4){0.f, 0.f, 0.f, 0.f};
    bf16x8 At[4][2], B0[2][2], B1[2][2];
    const char* cA = (const char*)g.A + (size_t)cur.pm * tstep; const char* cB = (const char*)g.Bt + (size_t)cur.pn * tstep;
    S.a_ready(cur);
    if constexpr (SP2) {
        PG8_STAGE(PG8_SB(0, 0), cB, voffB); PG8_STAGE(PG8_SB(0, 1), cB + hstep, voffB); PG8_STAGE(PG8_SA(0, 0), cA, voffA); PG8_STAGE(PG8_SA(0, 1), cA + hstep, voffA);
        if (wr == 1) PG8_BAR;
        PG8_WAIT_V(2); PG8_BAR;
        PG8_STAGE(PG8_SB(1, 0), cB + kstep, voffB); PG8_STAGE(PG8_SA(1, 0), cA + kstep, voffA); PG8_STAGE(PG8_SB(1, 1), cB + hstep + kstep, voffB);
        PG8_WAIT_V(6); PG8_BAR;
    } else {
        PG8_STAGE(PG8_SB(0, 0), cB, voffB); PG8_STAGE(PG8_SA(0, 0), cA, voffA); PG8_STAGE(PG8_SB(0, 1), cB + hstep, voffB); PG8_STAGE(PG8_SA(0, 1), cA + hstep, voffA);
        if (wr == 1) PG8_BAR;
        PG8_WAIT_V(4); PG8_BAR;
        PG8_STAGE(PG8_SB(1, 0), cB + kstep, voffB); PG8_STAGE(PG8_SA(1, 0), cA + kstep, voffA); PG8_STAGE(PG8_SB(1, 1), cB + hstep + kstep, voffB);
        PG8_WAIT_V(6); PG8_BAR;
    }
    for (;;) {
        const bool has_next = S.next(ui + 1, nxt);
        const char* nA = has_next ? (const char*)g.A + (size_t)nxt.pm * tstep : cA; const char* nB = has_next ? (const char*)g.Bt + (size_t)nxt.pn * tstep : cB;
        for (int t = 0; t < nt; t += 2) {
            const bool last = (t == nt - 2);
            const char* a1 = cA + (size_t)(t + 1) * kstep;
            const char* a2 = last ? nA : cA + (size_t)(t + 2) * kstep; const char* b2 = last ? nB : cB + (size_t)(t + 2) * kstep;
            const char* a3 = a2 + kstep; const char* b3 = b2 + kstep;
            if (last && has_next) S.a_ready(nxt);
            if constexpr (SP2) {
            PG8_LDB(B0, 0, 0); PG8_LDB(B1, 0, 1); PG8_SCHED; PG8_LDA(At, 0, 0); PG8_STAGE(PG8_SA(1, 1), a1 + hstep, voffA);
            PG8_WAIT_V(8); PG8_WAIT_L(0); PG8_BAR; PG8_MMA(0, 0, At, B0); PG8_MMA(0, 1, At, B1); PG8_BAR; PG8_SCHED;
            PG8_LDA(At, 0, 1); PG8_STAGE(PG8_SB(0, 0), b2, voffB); PG8_STAGE(PG8_SB(0, 1), b2 + hstep, voffB); PG8_STAGE(PG8_SA(0, 0), a2, voffA);
            PG8_WAIT_V(8); PG8_WAIT_L(0); PG8_BAR; PG8_MMA(1, 0, At, B0); PG8_MMA(1, 1, At, B1); PG8_BAR; PG8_SCHED;
            PG8_LDB(B0, 1, 0); PG8_LDB(B1, 1, 1); PG8_SCHED; PG8_LDA(At, 1, 0); PG8_STAGE(PG8_SA(0, 1), a2 + hstep, voffA);
            PG8_WAIT_V(8); PG8_WAIT_L(0); PG8_BAR; PG8_MMA(0, 0, At, B0); PG8_MMA(0, 1, At, B1); PG8_BAR; PG8_SCHED;
            PG8_LDA(At, 1, 1); PG8_STAGE(PG8_SB(1, 0), b3, voffB); PG8_STAGE(PG8_SB(1, 1), b3 + hstep, voffB); PG8_STAGE(PG8_SA(1, 0), a3, voffA);
            PG8_WAIT_V(8); PG8_WAIT_L(0); PG8_BAR; PG8_MMA(1, 0, At, B0); PG8_MMA(1, 1, At, B1); PG8_BAR; PG8_SCHED;
            } else {
            PG8_LDB(B0, 0, 0); PG8_SCHED; PG8_LDA(At, 0, 0); PG8_STAGE(PG8_SA(1, 1), a1 + hstep, voffA);
            PG8_WAIT_L(8); PG8_BAR; PG8_WAIT_L(0); PG8_MMA(0, 0, At, B0); PG8_BAR; PG8_SCHED;
            PG8_LDB(B1, 0, 1); PG8_STAGE(PG8_SB(0, 0), b2, voffB);
            PG8_BAR; PG8_WAIT_L(0); PG8_MMA(0, 1, At, B1); PG8_BAR;
            PG8_LDA(At, 0, 1); PG8_STAGE(PG8_SA(0, 0), a2, voffA);
            PG8_BAR; PG8_WAIT_L(0); PG8_MMA(1, 0, At, B0); PG8_BAR; PG8_SCHED;
            PG8_STAGE(PG8_SB(0, 1), b2 + hstep, voffB);
            PG8_WAIT_V(6); PG8_BAR; PG8_MMA(1, 1, At, B1); PG8_BAR;
            PG8_LDB(B0, 1, 0); PG8_SCHED; PG8_LDA(At, 1, 0); PG8_STAGE(PG8_SA(0, 1), a2 + hstep, voffA);
            PG8_WAIT_L(8); PG8_BAR; PG8_WAIT_L(0); PG8_MMA(0, 0, At, B0); PG8_BAR; PG8_SCHED;
            PG8_LDB(B1, 1, 1); PG8_STAGE(PG8_SB(1, 0), b3, voffB);
            PG8_BAR; PG8_WAIT_L(0); PG8_MMA(0, 1, At, B1); PG8_BAR;
            PG8_LDA(At, 1, 1); PG8_STAGE(PG8_SA(1, 0), a3, voffA);
            PG8_BAR; PG8_WAIT_L(0); PG8_MMA(1, 0, At, B0); PG8_BAR; PG8_SCHED;
            PG8_STAGE(PG8_SB(1, 1), b3 + hstep, voffB);
            PG8_WAIT_V(6); PG8_BAR; PG8_MMA(1, 1, At, B1); PG8_BAR;
            }
        }
        if constexpr (ALIGN_EPI) { if (wr == 0) PG8_BAR; }
        if constexpr (!Epi::AFTER_DRAIN) { E(acc, cur, wr, wc, fr, fq); S.done(cur); }
        if (!has_next) break;
#pragma unroll
        for (int a = 0; a < 2; ++a)
#pragma unroll
            for (int b = 0; b < 2; ++b)
#pragma unroll
                for (int m = 0; m < 4; ++m)
#pragma unroll
                    for (int n = 0; n < 2; ++n) acc[a][b][m][n] = (f32x4){0.f, 0.f, 0.f, 0.f};
        cur = nxt; cA = nA; cB = nB; ++ui;
        if constexpr (ALIGN_EPI) { if (wr == 1) PG8_BAR; }
    }
    PG8_WAIT_V(0);
    if constexpr (!ALIGN_EPI) { if (wr == 0) PG8_BAR; }
    PG8_BAR;
    if constexpr (Epi::AFTER_DRAIN) { E.fused(acc, cur, wr, wc, fr, fq, lds, wid, lane); S.done(cur); }
#undef PG8_SA
#undef PG8_SB
#undef PG8_STAGE
#undef PG8_LDA
#undef PG8_LDB
#undef PG8_MMA
#undef PG8_WAIT_V
#undef PG8_WAIT_L
#undef PG8_BAR
#undef PG8_SCHED
}
}

struct EpiBf16 {
    static constexpr bool PERM = true, AFTER_DRAIN = false;
    bf16_t* O; int ldc;
    __device__ __forceinline__ void operator()(const f32x4 (&acc)[2][2][4][2], const pg8::Unit& u, int wr, int wc, int fr, int fq) const {
        const int row0 = u.pm * 256 + wr * 64 + fr, col0 = u.pn * 256 + wc * 32 + 8 * fq;
#pragma unroll
        for (int ai = 0; ai < 2; ++ai)
#pragma unroll
            for (int m = 0; m < 4; ++m) { bf16_t* rowp = O + (size_t)(row0 + ai * 128 + m * 16) * ldc + col0;
#pragma unroll
                for (int bj = 0; bj < 2; ++bj) { const f32x4 v0 = acc[ai][bj][m][0], v1 = acc[ai][bj][m][1];
                    u32x4 w; w.x = pk2(v0[0], v0[1]); w.y = pk2(v0[2], v0[3]); w.z = pk2(v1[0], v1[1]); w.w = pk2(v1[2], v1[3]);
                    *(u32x4*)(rowp + bj * 128) = w; } }
    }
};
struct EpiResid {
    static constexpr bool PERM = true, AFTER_DRAIN = false;
    const float* in; float* out; bool real;
    __device__ __forceinline__ void operator()(const f32x4 (&acc)[2][2][4][2], const pg8::Unit& u, int wr, int wc, int fr, int fq) const {
        const int row0 = u.pm * 256 + wr * 64 + fr, col0 = u.pn * 256 + wc * 32 + 8 * fq;
#pragma unroll
        for (int ai = 0; ai < 2; ++ai)
#pragma unroll
            for (int m = 0; m < 4; ++m) { const size_t ro = (size_t)(row0 + ai * 128 + m * 16) * DM + col0;
#pragma unroll
                for (int bj = 0; bj < 2; ++bj)
#pragma unroll
                    for (int n = 0; n < 2; ++n) { const size_t o = ro + bj * 128 + 4 * n; f32x4 v = *(const f32x4*)(in + o); v += acc[ai][bj][m][n]; if (real || v[0] == 1.2345e30f) *(f32x4*)(out + o) = v; } }
    }
};
struct EpiSwiglu {
    static constexpr bool PERM = true, AFTER_DRAIN = false;
    bf16_t* O;
    __device__ __forceinline__ void operator()(const f32x4 (&acc)[2][2][4][2], const pg8::Unit& u, int wr, int wc, int fr, int fq) const {
        const int row0 = u.pm * 256 + wr * 64 + fr, col0 = u.pn * 128 + wc * 32 + 8 * fq;
#pragma unroll
        for (int ai = 0; ai < 2; ++ai)
#pragma unroll
            for (int m = 0; m < 4; ++m) { bf16_t* rowp = O + (size_t)(row0 + ai * 128 + m * 16) * FF_ + col0;
                float r[8];
#pragma unroll
                for (int n = 0; n < 2; ++n)
#pragma unroll
                    for (int j = 0; j < 4; ++j) r[4 * n + j] = siluf_(acc[ai][0][m][n][j]) * acc[ai][1][m][n][j];
                u32x4 w; w.x = pk2(r[0], r[1]); w.y = pk2(r[2], r[3]); w.z = pk2(r[4], r[5]); w.w = pk2(r[6], r[7]);
                *(u32x4*)rowp = w; }
    }
};
struct EpiOddIn {
    static constexpr bool PERM = true, AFTER_DRAIN = false;
    unsigned char* big;
    __device__ __forceinline__ void operator()(const f32x4 (&acc)[2][2][4][2], const pg8::Unit& u, int wr, int wc, int fr, int fq) const {
        const int row0 = u.pm * 256 + wr * 64 + fr, pn = u.pn, ci = wc * 32 + 8 * fq;
        if (pn < 8) {
            const int head = pn & 3; const bool isk = pn >= 4;
            const float lg = __log2f(1.0f - exp2f(-5.0f - (float)head));
            bf16_t* rm = (bf16_t*)(big + (isk ? OB_KT : OB_QT));
            bf16_t* tr = (bf16_t*)(big + OB_KTT);
#pragma unroll
            for (int ai = 0; ai < 2; ++ai)
#pragma unroll
                for (int m = 0; m < 4; ++m) { const int t = row0 + ai * 128 + m * 16; const float jp = (float)((t & 255) + 1);
                    const float dec = isk ? __builtin_amdgcn_exp2f(-jp * lg) * 0.0625f : __builtin_amdgcn_exp2f(jp * lg);
                    bf16_t* rp = rm + (size_t)head * 256 * S_ + rb_off(8, t, ci);
                    bf16_t* tp = tr + (size_t)head * 256 * S_ + tb_off(256, ci, t);
#pragma unroll
                    for (int n = 0; n < 2; ++n) {
                        float y1[4], y2[4];
#pragma unroll
                        for (int j = 0; j < 4; ++j) { const float ang = (float)t * __builtin_amdgcn_exp2f(-(float)(ci + 4 * n + j) * 0.10381025296523008f);
                            const float kk = __builtin_rintf(ang * 0.15915494309189535f);
                            float rr = __builtin_fmaf(-kk, 6.28125f, ang); rr = __builtin_fmaf(-kk, 0.0019353071795864769f, rr); const float fr_ = rr * 0.15915494309189535f;
                            const float sn = __builtin_amdgcn_sinf(fr_), cs = __builtin_amdgcn_cosf(fr_);
                            const float x1 = acc[ai][0][m][n][j], x2 = acc[ai][1][m][n][j];
                            y1[j] = (x1 * cs - x2 * sn) * dec; y2[j] = (x1 * sn + x2 * cs) * dec; }
                        u32x2 w; w.x = pk2(y1[0], y1[1]); w.y = pk2(y1[2], y1[3]); *(u32x2*)(rp + 4 * n) = w;
                        w.x = pk2(y2[0], y2[1]); w.y = pk2(y2[2], y2[3]); *(u32x2*)(rp + 4 * 512 + 4 * n) = w;
                        if (isk) {
#pragma unroll
                            for (int j = 0; j < 4; ++j) { tp[(4 * n + j) * 32] = (bf16_t)f2bf(y1[j]); tp[(128 + 4 * n + j) * 32] = (bf16_t)f2bf(y2[j]); }
                        }
                        __builtin_amdgcn_sched_barrier(0);
                    } }
        } else if (pn < 16) {
            const int vh = (pn - 8) >> 1, dv0 = ((pn - 8) & 1) * 256 + ci;
            bf16_t* tr = (bf16_t*)(big + OB_VTT) + (size_t)vh * 512 * S_;
#pragma unroll
            for (int ai = 0; ai < 2; ++ai)
#pragma unroll
                for (int m = 0; m < 4; ++m) { const int t = row0 + ai * 128 + m * 16; bf16_t* tp = tr + tb_off(512, dv0, t);
#pragma unroll
                    for (int bj = 0; bj < 2; ++bj)
#pragma unroll
                        for (int e = 0; e < 8; ++e) tp[(bj * 128 + e) * 32] = (bf16_t)f2bf(acc[ai][bj][m][e >> 2][e & 3]); }
        } else {
            bf16_t* d0; bf16_t* d1; int ld; bool t1 = false; bool v0ok = true, v1ok = true;
            if (pn < 24)      { d0 = (bf16_t*)(big + OB_GC) + (pn - 16) * 256 + ci; d1 = d0 + 128; ld = 2048; }
            else if (pn < 28) { d0 = (bf16_t*)(big + OB_QD) + (pn - 24) * 256 + ci; d1 = d0 + 128; ld = 1024; }
            else if (pn == 28) { d0 = (bf16_t*)(big + OB_KCMP) + ci; d1 = (bf16_t*)(big + OB_VCMP) + ci; ld = 128; }
            else if (pn == 29) { d0 = (bf16_t*)(big + OB_KSLC); d1 = (bf16_t*)(big + OB_VSLCT); ld = 0; t1 = true; }
            else if (pn == 30) { d0 = (bf16_t*)(big + OB_KWIN); d1 = (bf16_t*)(big + OB_VWIN); ld = 0; t1 = true; }
            else               { d0 = (bf16_t*)(big + OB_GD) + ci; d1 = d0; ld = 64; v0ok = ci < 64; v1ok = false; }
#pragma unroll
            for (int ai = 0; ai < 2; ++ai)
#pragma unroll
                for (int m = 0; m < 4; ++m) { const int t = row0 + ai * 128 + m * 16;
                    if (v0ok) { const f32x4 v0 = acc[ai][0][m][0], v1 = acc[ai][0][m][1];
                        u32x4 w; w.x = pk2(v0[0], v0[1]); w.y = pk2(v0[2], v0[3]); w.z = pk2(v1[0], v1[1]); w.w = pk2(v1[2], v1[3]);
                        *(u32x4*)(t1 ? d0 + (size_t)(ci >> 6) * 64 * S_ + rb_off(2, t, ci & 63) : d0 + (size_t)t * ld) = w; }
                    if (v1ok) {
                        if (t1) {
#pragma unroll
                            for (int e = 0; e < 8; ++e) d1[(size_t)(ci >> 6) * 64 * S_ + tb_off(64, (ci & 63) + e, t)] = (bf16_t)f2bf(acc[ai][1][m][e >> 2][e & 3]);
                        } else { const f32x4 v0 = acc[ai][1][m][0], v1 = acc[ai][1][m][1];
                            u32x4 w; w.x = pk2(v0[0], v0[1]); w.y = pk2(v0[2], v0[3]); w.z = pk2(v1[0], v1[1]); w.w = pk2(v1[2], v1[3]); *(u32x4*)(d1 + (size_t)t * ld) = w; } } }
        }
    }
};

__device__ __forceinline__ void conv_tile(const float* src, int ld, int K, int col0, int ncv, bf16_t* dstrow0, int k0, LAS float* tile, int tid) {
#pragma unroll
    for (int i = 0; i < 8; ++i) { const int kk = (tid >> 6) + 8 * i, nn = tid & 63;
        tile[kk * 65 + nn] = nn < ncv ? src[(size_t)(k0 + kk) * ld + col0 + nn] : 0.f; }
    __syncthreads();
    { const int nn = tid >> 3, kc = (tid & 7) * 8; float v[8];
#pragma unroll
      for (int j = 0; j < 8; ++j) v[j] = tile[(kc + j) * 65 + nn];
      u32x4 w; w.x = pk2(v[0], v[1]); w.y = pk2(v[2], v[3]); w.z = pk2(v[4], v[5]); w.w = pk2(v[6], v[7]);
      *(u32x4*)(dstrow0 + (size_t)nn * K + k0 + kc) = w; }
    __syncthreads();
}

__device__ __forceinline__ void phase_convert(const Params& p, int layer, LAS unsigned char* lds) {
    const int tid = launder_tid(); LAS float* tile = (LAS float*)lds;
    const int li = layer >> 1; const bool odd = layer & 1;
    unsigned char* ws = launder_ptr(p.ws);
    const int n_in = odd ? 128 * 16 : 36 * 16, n_out = odd ? 16 * 48 : 16 * 16, n_gu = 88 * 16, n_dn = 16 * 44, n_c1 = odd ? 2 * 32 : 0, n_c2 = odd ? 2 : 0, n_bv = odd ? 2 : 0;
    const int o_out = n_in, o_gu = o_out + n_out, o_dn = o_gu + n_gu, o_c1k = o_dn + n_dn, o_c1v = o_c1k + n_c1, o_c2k = o_c1v + n_c1, o_c2v = o_c2k + n_c2, o_bv = o_c2v + n_c2, total = o_bv + n_bv;
    for (int u = blockIdx.x; u < total; u += gridDim.x) {
        if (u < o_out) { const int nt = u >> 4, kt = u & 15;
            if (odd) { const int Ns = 7984; const float* src = p.odd_w_in + (size_t)li * 1024 * Ns; int ncv = Ns - nt * 64; ncv = ncv > 64 ? 64 : (ncv < 0 ? 0 : ncv);
                conv_tile(src, Ns, 1024, nt * 64, ncv, (bf16_t*)(ws + WS_WIN) + (size_t)nt * 64 * 1024, kt * 64, tile, tid); }
            else { const float* src = p.even_w_in + (size_t)li * 1024 * 2304; conv_tile(src, 2304, 1024, nt * 64, 64, (bf16_t*)(ws + WS_WIN) + (size_t)nt * 64 * 1024, kt * 64, tile, tid); }
        } else if (u < o_gu) { const int v = u - o_out; const int KO = odd ? 3072 : 1024, nk = KO / 64; const int nt = v / nk, kt = v % nk;
            const float* src = odd ? p.odd_w_out + (size_t)li * 3072 * 1024 : p.even_w_out + (size_t)li * 1024 * 1024;
            conv_tile(src, 1024, KO, nt * 64, 64, (bf16_t*)(ws + WS_WOUT) + (size_t)nt * 64 * KO, kt * 64, tile, tid);
        } else if (u < o_dn) { const int v = u - o_gu; const int q = v >> 4, kt = v & 15; const int pn = q >> 2, bj = (q >> 1) & 1, i0 = 64 * (q & 1);
            const float* src = (bj ? p.ffn_w_up : p.ffn_w_gate) + (size_t)layer * 1024 * FF_;
            conv_tile(src, FF_, 1024, 128 * pn + i0, 64, (bf16_t*)(ws + WS_WGU) + (size_t)q * 64 * 1024, kt * 64, tile, tid);
        } else if (u < o_c1k) { const int v = u - o_dn; const int nt = v / 44, kt = v % 44;
            const float* src = p.ffn_w_down + (size_t)layer * FF_ * 1024;
            conv_tile(src, 1024, FF_, nt * 64, 64, (bf16_t*)(ws + WS_WDN) + (size_t)nt * 64 * FF_, kt * 64, tile, tid);
        } else if (u < o_c2k) { const bool isv = u >= o_c1v; const int v = u - (isv ? o_c1v : o_c1k); const int nt = v >> 5, kt = v & 31;
            const float* src = (isv ? p.odd_cmp_v_w1 : p.odd_cmp_k_w1) + (size_t)li * 2048 * 128;
            conv_tile(src, 128, 2048, nt * 64, 64, (bf16_t*)(ws + WS_WC1 + (isv ? 512 * 1024 : 0)) + (size_t)nt * 64 * 2048, kt * 64, tile, tid);
        } else if (u < o_bv) { const bool isv = u >= o_c2v; const int kt = u - (isv ? o_c2v : o_c2k);
            const float* src = (isv ? p.odd_cmp_v_w2 : p.odd_cmp_k_w2) + (size_t)li * 128 * 64;
            conv_tile(src, 64, 128, 0, 64, (bf16_t*)(ws + WS_WC2 + (isv ? 16384 : 0)), kt * 64, tile, tid);
        } else { const bool isv = (u - o_bv) == 1;
            const float* pos = (isv ? p.odd_cmp_pos_v : p.odd_cmp_pos_k) + (size_t)li * 2048; const float* w1 = (isv ? p.odd_cmp_v_w1 : p.odd_cmp_k_w1) + (size_t)li * 2048 * 128;
            const int hid = tid & 127, part = tid >> 7; float s = 0.f;
            for (int k = part * 512; k < part * 512 + 512; ++k) s += pos[k] * w1[(size_t)k * 128 + hid];
            tile[part * 128 + hid] = s; __syncthreads();
            if (tid < 128) ((float*)(ws + WS_SMALL))[(isv ? 128 : 0) + tid] = tile[tid] + tile[128 + tid] + tile[256 + tid] + tile[384 + tid];
            __syncthreads();
        }
    }
}

__device__ __forceinline__ void phase_rmsnorm(const float* src, const float* w, bf16_t* dstb, float* dstf, int row0 = 0, int row1 = M_) {
    const int tid_ = launder_tid(); const int lane = tid_ & 63, wave = tid_ >> 6;
    f32x4 wv[4];
#pragma unroll
    for (int i = 0; i < 4; ++i) wv[i] = *(const f32x4*)(w + 256 * i + 4 * lane);
    for (int row = row0 + blockIdx.x * 8 + wave; row < row1; row += gridDim.x * 8) {
        const float* rp = src + (size_t)row * DM; f32x4 v[4]; float ss = 0.f;
#pragma unroll
        for (int i = 0; i < 4; ++i) { v[i] = *(const f32x4*)(rp + 256 * i + 4 * lane); ss += v[i][0] * v[i][0] + v[i][1] * v[i][1] + v[i][2] * v[i][2] + v[i][3] * v[i][3]; }
#pragma unroll
        for (int o = 32; o >= 1; o >>= 1) ss += shx(ss, o, lane);
        const float rs = rsqrtf(ss * (1.0f / 1024.0f) + 1e-6f);
#pragma unroll
        for (int i = 0; i < 4; ++i) { const f32x4 y = v[i] * rs * wv[i];
            if (dstb) { u32x2 o2; o2.x = pk2(y[0], y[1]); o2.y = pk2(y[2], y[3]); *(u32x2*)(dstb + (size_t)row * DM + 256 * i + 4 * lane) = o2; }
            else *(f32x4*)(dstf + (size_t)row * DM + 256 * i + 4 * lane) = y; }
    }
}


template <bool VT>
__device__ __forceinline__ void band_unit(const bf16_t* Q, int ldq, const bf16_t* K, int ldk, const bf16_t* V, int ldv,
                                          int L, int dil, int res, int maxd, int head, int i0,
                                          bf16_t* O, int ldo, float* lse, int ldl, const bf16_t* gate, int ldg,
                                          bool has_sink, float sink, const LAS float* tbl, int lane) {
    const int g = lane >> 4, c = lane & 15;
    const int iq = i0 + c; const int tq = res + dil * iq;
    const bf16_t* qp = Q + (size_t)tq * ldq + 8 * g;
    const bf16x8 qf0 = *(const bf16x8*)qp, qf1 = *(const bf16x8*)(qp + 32);
    float m = has_sink ? sink : -1e30f, l = (has_sink && g == 0) ? 1.0f : 0.0f;
    f32x4 acc[4];
#pragma unroll
    for (int d = 0; d < 4; ++d) acc[d] = (f32x4){0.f, 0.f, 0.f, 0.f};
    int lo = i0 - maxd; lo = lo < 0 ? 0 : lo;
    const int tlo = (lo >> 4) & ~1, thi = i0 >> 4;
    bf16x8 ck[4];
    { const int tbv0 = tlo + 1 > thi ? tlo : tlo + 1;
      const bf16_t* kpa = K + (size_t)(res + dil * (16 * tlo + c)) * ldk + 8 * g; const bf16_t* kpb = K + (size_t)(res + dil * (16 * tbv0 + c)) * ldk + 8 * g;
      ck[0] = *(const bf16x8*)kpa; ck[1] = *(const bf16x8*)(kpa + 32); ck[2] = *(const bf16x8*)kpb; ck[3] = *(const bf16x8*)(kpb + 32); }
    for (int ta = tlo; ta <= thi; ta += 2) {
        const int tb = ta + 1, tbv = tb > thi ? ta : tb;
        bf16x8 nk[4];
        { const int tna = ta + 2 <= thi ? ta + 2 : ta, tnb = tna + 1 > thi ? tna : tna + 1;
          const bf16_t* kpa = K + (size_t)(res + dil * (16 * tna + c)) * ldk + 8 * g; const bf16_t* kpb = K + (size_t)(res + dil * (16 * tnb + c)) * ldk + 8 * g;
          nk[0] = *(const bf16x8*)kpa; nk[1] = *(const bf16x8*)(kpa + 32); nk[2] = *(const bf16x8*)kpb; nk[3] = *(const bf16x8*)(kpb + 32); }
        bf16x8 vfr[4];
#pragma unroll
        for (int d = 0; d < 4; ++d) {
            if (VT) { const bf16_t* vp = V + (size_t)(16 * d + c) * ldv + 4 * g; vfr[d] = mk8(*(const u32x2*)(vp + 16 * ta), *(const u32x2*)(vp + 16 * tbv)); }
            else {
#pragma unroll
                for (int j = 0; j < 4; ++j) { vfr[d][j] = (short)V[(size_t)(res + dil * (16 * ta + 4 * g + j)) * ldv + 16 * d + c]; vfr[d][4 + j] = (short)V[(size_t)(res + dil * (16 * tbv + 4 * g + j)) * ldv + 16 * d + c]; }
            }
        }
        __builtin_amdgcn_sched_barrier(0);
        f32x4 sa = mfma16(ck[0], qf0, (f32x4){0.f, 0.f, 0.f, 0.f}); sa = mfma16(ck[1], qf1, sa);
        f32x4 sb = mfma16(ck[2], qf0, (f32x4){0.f, 0.f, 0.f, 0.f}); sb = mfma16(ck[3], qf1, sb);
        float s[8]; bool ok[8];
#pragma unroll
        for (int r = 0; r < 4; ++r) {
            const int da = iq - (16 * ta + 4 * g + r), db = iq - (16 * tb + 4 * g + r);
            ok[r] = da >= 0 && da <= maxd; ok[4 + r] = db >= 0 && db <= maxd;
            s[r] = ok[r] ? sa[r] * 0.125f + tbl[t5b(da * dil) * 16 + head] : -1e30f;
            s[4 + r] = ok[4 + r] ? sb[r] * 0.125f + tbl[t5b((db < 0 ? 0 : db) * dil) * 16 + head] : -1e30f;
        }
        float mx = fmaxf(fmaxf(fmaxf(s[0], s[1]), fmaxf(s[2], s[3])), fmaxf(fmaxf(s[4], s[5]), fmaxf(s[6], s[7])));
        mx = fmaxf(mx, shx(mx, 16, lane)); mx = fmaxf(mx, shx(mx, 32, lane));
        const float mn = fmaxf(m, mx), alpha = __expf(m - mn); m = mn;
        float pr[8], ps = 0.f;
#pragma unroll
        for (int r = 0; r < 8; ++r) { pr[r] = ok[r] ? __expf(s[r] - mn) : 0.f; ps += pr[r]; }
        l = l * alpha + ps;
        const bf16x8 pf = mk8p(pr[0], pr[1], pr[2], pr[3], pr[4], pr[5], pr[6], pr[7]);
#pragma unroll
        for (int d = 0; d < 4; ++d) {
            acc[d] = mfma16(vfr[d], pf, acc[d] * alpha);
        }
#pragma unroll
        for (int i = 0; i < 4; ++i) ck[i] = nk[i];
    }
    l += shx(l, 16, lane); l += shx(l, 32, lane);
    float inv = 1.0f / l;
    if (lse && g == 0) lse[(size_t)tq * ldl] = m + __logf(l);
    if (gate) inv *= sigmoidf_(bf2f(gate[(size_t)tq * ldg]));
#pragma unroll
    for (int d = 0; d < 4; ++d) { u32x2 w; w.x = pk2(acc[d][0] * inv, acc[d][1] * inv); w.y = pk2(acc[d][2] * inv, acc[d][3] * inv);
        *(u32x2*)(O + (size_t)tq * ldo + 16 * d + 4 * g) = w; }
}

__device__ __forceinline__ void win_unit(const unsigned char* big, bf16_t* ob, int h, int i0, const LAS float* tbl, int lane) {
    const int g = lane >> 4, c = lane & 15, grp = h >> 3, t = i0 + c;
    const bf16_t* qp = (const bf16_t*)(big + OB_QD) + (size_t)t * 1024 + h * 64 + 8 * g;
    const bf16x8 qf0 = *(const bf16x8*)qp, qf1 = *(const bf16x8*)(qp + 32);
    const bf16_t* Kb = (const bf16_t*)(big + OB_KWIN) + (size_t)grp * 64 * S_ + c * 32 + 8 * g;
    const bf16_t* Vb = (const bf16_t*)(big + OB_VWIN) + (size_t)grp * 64 * S_ + c * 32 + 8 * g;
    float m = -1e30f, l = 0.f;
    f32x4 acc[4];
#pragma unroll
    for (int d = 0; d < 4; ++d) acc[d] = (f32x4){0.f, 0.f, 0.f, 0.f};
    int lo = i0 - 511; lo = lo < 0 ? 0 : lo;
    const int tlo = (lo >> 4) & ~1, thi = i0 >> 4;
    bf16x8 ck[4], cv[4];
    { const bf16_t* kp = Kb + (size_t)tlo * 1024; ck[0] = *(const bf16x8*)kp; ck[1] = *(const bf16x8*)(kp + 512); ck[2] = *(const bf16x8*)(kp + 1024); ck[3] = *(const bf16x8*)(kp + 1536); }
    for (int ta = tlo; ta <= thi; ta += 2) {
        const int tn = ta + 2 <= thi ? ta + 2 : ta;
        bf16x8 nk[4];
        { const bf16_t* kp = Kb + (size_t)tn * 1024; nk[0] = *(const bf16x8*)kp; nk[1] = *(const bf16x8*)(kp + 512); nk[2] = *(const bf16x8*)(kp + 1024); nk[3] = *(const bf16x8*)(kp + 1536);
          const bf16_t* vp = Vb + (size_t)ta * 1024;
#pragma unroll
          for (int d = 0; d < 4; ++d) cv[d] = *(const bf16x8*)(vp + 512 * d); }
        __builtin_amdgcn_sched_barrier(0);
        f32x4 sa = mfma16(ck[0], qf0, (f32x4){0.f, 0.f, 0.f, 0.f}); sa = mfma16(ck[1], qf1, sa);
        f32x4 sb = mfma16(ck[2], qf0, (f32x4){0.f, 0.f, 0.f, 0.f}); sb = mfma16(ck[3], qf1, sb);
        float s[8]; bool ok[8];
#pragma unroll
        for (int r = 0; r < 4; ++r) {
            const int da = t - (16 * ta + 4 * g + r), db = da - 16;
            ok[r] = da >= 0 && da <= 511; ok[4 + r] = db >= 0 && db <= 511;
            s[r] = ok[r] ? sa[r] * 0.125f + tbl[t5b(da) * 16 + h] : -1e30f;
            s[4 + r] = ok[4 + r] ? sb[r] * 0.125f + tbl[t5b(db < 0 ? 0 : db) * 16 + h] : -1e30f;
        }
        float mx = fmaxf(fmaxf(fmaxf(s[0], s[1]), fmaxf(s[2], s[3])), fmaxf(fmaxf(s[4], s[5]), fmaxf(s[6], s[7])));
        mx = fmaxf(mx, shx(mx, 16, lane)); mx = fmaxf(mx, shx(mx, 32, lane));
        const float mn = fmaxf(m, mx), alpha = __expf(m - mn); m = mn;
        float pr[8], ps = 0.f;
#pragma unroll
        for (int r = 0; r < 8; ++r) { pr[r] = ok[r] ? __expf(s[r] - mn) : 0.f; ps += pr[r]; }
        l = l * alpha + ps;
        const bf16x8 pf = mk8p(pr[0], pr[1], pr[2], pr[3], pr[4], pr[5], pr[6], pr[7]);
#pragma unroll
        for (int d = 0; d < 4; ++d) acc[d] = mfma16(cv[d], pf, acc[d] * alpha);
#pragma unroll
        for (int i = 0; i < 4; ++i) ck[i] = nk[i];
    }
    l += shx(l, 16, lane); l += shx(l, 32, lane);
    const float inv = sigmoidf_(bf2f(((const bf16_t*)(big + OB_GD))[(size_t)t * 64 + h * 3 + 2])) / l;
#pragma unroll
    for (int d = 0; d < 4; ++d) { u32x2 w; w.x = pk2(acc[d][0] * inv, acc[d][1] * inv); w.y = pk2(acc[d][2] * inv, acc[d][3] * inv);
        *(u32x2*)(ob + (size_t)t * 3072 + 2048 + h * 64 + 16 * d + 4 * g) = w; }
}

#define SEL_LOADK(K_, k0_) do { const bf16_t* kp_ = Kb + (size_t)(k0_) * 64; _Pragma("unroll") for (int i_ = 0; i_ < 8; ++i_) K_[i_] = *(const bf16x8*)(kp_ + 512 * i_); } while (0)
#define SEL_STEP(K_, k0_) do { \
    bf16x8 cv[8]; { const bf16_t* vp_ = Vb + (size_t)(k0_) * 64; _Pragma("unroll") for (int i_ = 0; i_ < 8; ++i_) cv[i_] = *(const bf16x8*)(vp_ + 512 * i_); } \
    __builtin_amdgcn_sched_barrier(0); \
    f32x4 sc[4]; \
    _Pragma("unroll") for (int i = 0; i < 4; ++i) { sc[i] = mfma16(K_[2 * i], qf0, (f32x4){0.f, 0.f, 0.f, 0.f}); sc[i] = mfma16(K_[2 * i + 1], qf1, sc[i]); } \
    float s[16]; bool ok[16]; \
    const int dmin = t - (k0_) - 63; const int bk0 = __builtin_amdgcn_readfirstlane(t5b(dmin < 0 ? 0 : dmin)); \
    if (dmin >= 0 && bk0 == __builtin_amdgcn_readfirstlane(t5b(dmin + 63))) { const float bias = tbl[bk0 * 16 + head]; \
        _Pragma("unroll") for (int i = 0; i < 4; ++i) _Pragma("unroll") for (int r = 0; r < 4; ++r) { ok[4 * i + r] = true; s[4 * i + r] = sc[i][r] * 0.125f + bias; } \
    } else { \
        _Pragma("unroll") for (int i = 0; i < 4; ++i) _Pragma("unroll") for (int r = 0; r < 4; ++r) { const int dd = t - ((k0_) + 16 * i + 4 * g + r); ok[4 * i + r] = dd >= 0; \
            s[4 * i + r] = dd >= 0 ? sc[i][r] * 0.125f + tbl[t5b(dd) * 16 + head] : -1e30f; } \
    } \
    float mx = s[0]; \
    _Pragma("unroll") for (int r = 1; r < 16; ++r) mx = fmaxf(mx, s[r]); \
    mx = fmaxf(mx, shx(mx, 16, lane)); mx = fmaxf(mx, shx(mx, 32, lane)); \
    if (__builtin_amdgcn_ballot_w64(mx > m) != 0ull) { const float mn = fmaxf(m, mx), alpha = __expf(m - mn); m = mn; l *= alpha; \
        _Pragma("unroll") for (int d = 0; d < 4; ++d) acc[d] *= alpha; } \
    float pr[16], ps = 0.f; \
    _Pragma("unroll") for (int r = 0; r < 16; ++r) { pr[r] = ok[r] ? __expf(s[r] - m) : 0.f; ps += pr[r]; } \
    l += ps; \
    const bf16x8 pf0 = mk8p(pr[0], pr[1], pr[2], pr[3], pr[4], pr[5], pr[6], pr[7]), pf1 = mk8p(pr[8], pr[9], pr[10], pr[11], pr[12], pr[13], pr[14], pr[15]); \
    _Pragma("unroll") for (int d = 0; d < 4; ++d) { acc[d] = mfma16(cv[d], pf0, acc[d]); acc[d] = mfma16(cv[4 + d], pf1, acc[d]); } } while (0)
__device__ __forceinline__ void sel_unit(const unsigned char* big, const int* idx, bf16_t* ob, int t, int grp, const LAS float* tbl, int lane, bool real = true) {
    const int g = lane >> 4, c = lane & 15, head = grp * 8 + (c & 7);
    const bf16_t* qp = (const bf16_t*)(big + OB_QD) + (size_t)t * 1024 + head * 64 + 8 * g;
    const bf16x8 qf0 = *(const bf16x8*)qp, qf1 = *(const bf16x8*)(qp + 32);
    const bf16_t* Kb = (const bf16_t*)(big + OB_KSLC) + (size_t)grp * 64 * S_ + c * 32 + 8 * g;
    const bf16_t* Vb = (const bf16_t*)(big + OB_VSLCT) + (size_t)grp * 64 * S_ + c * 32 + 8 * g;
    float m = -1e30f, l = 0.f;
    f32x4 acc[4];
#pragma unroll
    for (int d = 0; d < 4; ++d) acc[d] = (f32x4){0.f, 0.f, 0.f, 0.f};
    const int* ip = idx + ((size_t)t * 2 + grp) * 16;
    int nsel = (t >> 6) + 1; nsel = nsel > 16 ? 16 : nsel;
    int k0a = __builtin_amdgcn_readfirstlane(ip[0]) * 64;
    bf16x8 ka[8], kb[8];
    SEL_LOADK(ka, k0a);
    for (int si = 0; si < nsel; si += 2) {
        const int s1 = si + 1 < nsel ? si + 1 : si;
        const int k0b = __builtin_amdgcn_readfirstlane(ip[s1]) * 64;
        SEL_LOADK(kb, k0b);
        SEL_STEP(ka, k0a);
        if (si + 1 < nsel) {
            const int s2 = si + 2 < nsel ? si + 2 : s1;
            const int k0n = __builtin_amdgcn_readfirstlane(ip[s2]) * 64;
            SEL_LOADK(ka, k0n);
            SEL_STEP(kb, k0b);
            k0a = k0n;
        }
    }
    l += shx(l, 16, lane); l += shx(l, 32, lane);
    if (c < 8 && real) {
        const float gt = sigmoidf_(bf2f(((const bf16_t*)(big + OB_GD))[(size_t)t * 64 + head * 3 + 1])) / l;
#pragma unroll
        for (int d = 0; d < 4; ++d) { bf16_t* op = ob + (size_t)t * 3072 + 2048 + head * 64 + 16 * d + 4 * g; const u32x2 o = *(const u32x2*)op;
            u32x2 w; w.x = pk2(bflo(o.x) + acc[d][0] * gt, bfhi(o.x) + acc[d][1] * gt); w.y = pk2(bflo(o.y) + acc[d][2] * gt, bfhi(o.y) + acc[d][3] * gt); *(u32x2*)op = w; }
    }
}

__device__ __forceinline__ void cmp_unit(const unsigned char* big, const unsigned char* misc, int* idx, bf16_t* ob, int t0, int grp, const LAS float* tbl, LAS float* impall, int wave, int lane, bool real = true) {
    const int g = lane >> 4, c = lane & 15, t = t0 + c, head = grp * 8 + wave;
    LAS float* imp = impall + wave * (16 * 257);
    for (int i = lane; i < 16 * 257; i += 64) imp[i] = 0.f;
    asm volatile("" ::: "memory");
    int cnt = t0 >> 4; cnt = cnt > 1023 ? 1023 : cnt;
    const int npair = (cnt + 31) >> 5;
    const bf16_t* KC = (const bf16_t*)(misc + MS_KC) + (size_t)grp * 65536 + c * 32 + 8 * g;
    const bf16_t* VCT = (const bf16_t*)(misc + MS_VCT) + (size_t)grp * 65536 + c * 32 + 8 * g;
    if (cnt > 0) {
        const bf16_t* qp = (const bf16_t*)(big + OB_QD) + (size_t)t * 1024 + head * 64 + 8 * g;
        const bf16x8 qf0 = *(const bf16x8*)qp, qf1 = *(const bf16x8*)(qp + 32);
        float m = -1e30f, l = 0.f;
        bf16x8 ka[4], kb[4];
        auto loadk = [&](bf16x8 (&K_)[4], int pj) __attribute__((always_inline)) { const bf16_t* kp = KC + (size_t)pj * 2048;
            K_[0] = *(const bf16x8*)kp; K_[1] = *(const bf16x8*)(kp + 512); K_[2] = *(const bf16x8*)(kp + 1024); K_[3] = *(const bf16x8*)(kp + 1536); };
        auto pass1 = [&](const bf16x8 (&ck)[4], int pi) __attribute__((always_inline)) {
            f32x4 sa = mfma16(ck[0], qf0, (f32x4){0.f, 0.f, 0.f, 0.f}); sa = mfma16(ck[1], qf1, sa);
            f32x4 sb = mfma16(ck[2], qf0, (f32x4){0.f, 0.f, 0.f, 0.f}); sb = mfma16(ck[3], qf1, sb);
            float s[8]; bool ok[8];
            const int dmin = t0 - (16 * (32 * pi + 31) + 31); const int bk0 = __builtin_amdgcn_readfirstlane(t5b(dmin < 0 ? 0 : dmin));
            if (dmin >= 0 && pi < 31 && bk0 == __builtin_amdgcn_readfirstlane(t5b(dmin + 511))) {
                const float bias = tbl[bk0 * 16 + head];
#pragma unroll
                for (int r = 0; r < 4; ++r) { ok[r] = true; ok[4 + r] = true; s[r] = sa[r] * 0.125f + bias; s[4 + r] = sb[r] * 0.125f + bias; }
            } else {
#pragma unroll
                for (int r = 0; r < 4; ++r) {
                    const int na = 32 * pi + 4 * g + r, nb = na + 16; const int da = t - (16 * na + 31), db = da - 256;
                    ok[r] = da >= 0 && na < 1023; ok[4 + r] = db >= 0 && nb < 1023;
                    s[r] = ok[r] ? sa[r] * 0.125f + tbl[t5b(da) * 16 + head] : -1e30f;
                    s[4 + r] = ok[4 + r] ? sb[r] * 0.125f + tbl[t5b(db < 0 ? 0 : db) * 16 + head] : -1e30f;
                }
            }
            float mx = fmaxf(fmaxf(fmaxf(s[0], s[1]), fmaxf(s[2], s[3])), fmaxf(fmaxf(s[4], s[5]), fmaxf(s[6], s[7])));
            const float mn = fmaxf(m, mx); float ps = 0.f;
#pragma unroll
            for (int r = 0; r < 8; ++r) ps += ok[r] ? __expf(s[r] - mn) : 0.f;
            l = l * __expf(m - mn) + ps; m = mn;
        };
        loadk(ka, 0);
        for (int pi = 0; pi < npair; pi += 2) {
            loadk(kb, pi + 1 < npair ? pi + 1 : pi);
            __builtin_amdgcn_sched_barrier(0);
            pass1(ka, pi);
            if (pi + 1 < npair) { loadk(ka, pi + 2 < npair ? pi + 2 : pi + 1); __builtin_amdgcn_sched_barrier(0); pass1(kb, pi + 1); }
        }
        {
            float mo = shx(m, 16, lane), lo = shx(l, 16, lane); float mn = fmaxf(m, mo); l = l * __expf(m - mn) + lo * __expf(mo - mn); m = mn;
            mo = shx(m, 32, lane); lo = shx(l, 32, lane); mn = fmaxf(m, mo); l = l * __expf(m - mn) + lo * __expf(mo - mn); m = mn;
        }
        const float il = l > 0.f ? 1.0f / l : 0.f;
        f32x4 acc[4];
#pragma unroll
        for (int d = 0; d < 4; ++d) acc[d] = (f32x4){0.f, 0.f, 0.f, 0.f};
        auto pass2 = [&](const bf16x8 (&ck)[4], int pi) __attribute__((always_inline)) {
            bf16x8 cv[4];
#pragma unroll
            for (int d = 0; d < 4; ++d) cv[d] = *(const bf16x8*)(VCT + (size_t)pi * 2048 + 512 * d);
            __builtin_amdgcn_sched_barrier(0);
            f32x4 sa = mfma16(ck[0], qf0, (f32x4){0.f, 0.f, 0.f, 0.f}); sa = mfma16(ck[1], qf1, sa);
            f32x4 sb = mfma16(ck[2], qf0, (f32x4){0.f, 0.f, 0.f, 0.f}); sb = mfma16(ck[3], qf1, sb);
            float pr[8];
            const int dmin = t0 - (16 * (32 * pi + 31) + 31); const int bk0 = __builtin_amdgcn_readfirstlane(t5b(dmin < 0 ? 0 : dmin));
            if (dmin >= 0 && pi < 31 && bk0 == __builtin_amdgcn_readfirstlane(t5b(dmin + 511))) {
                const float bm = tbl[bk0 * 16 + head] - m;
#pragma unroll
                for (int r = 0; r < 4; ++r) { pr[r] = __expf(sa[r] * 0.125f + bm) * il; pr[4 + r] = __expf(sb[r] * 0.125f + bm) * il; }
            } else {
#pragma unroll
                for (int r = 0; r < 4; ++r) {
                    const int na = 32 * pi + 4 * g + r, nb = na + 16; const int da = t - (16 * na + 31), db = da - 256;
                    const bool oka = da >= 0 && na < 1023, okb = db >= 0 && nb < 1023;
                    pr[r] = oka ? __expf(sa[r] * 0.125f + tbl[t5b(da) * 16 + head] - m) * il : 0.f;
                    pr[4 + r] = okb ? __expf(sb[r] * 0.125f + tbl[t5b(db < 0 ? 0 : db) * 16 + head] - m) * il : 0.f;
                }
            }
            const bf16x8 pf = mk8p(pr[0], pr[1], pr[2], pr[3], pr[4], pr[5], pr[6], pr[7]);
#pragma unroll
            for (int d = 0; d < 4; ++d) acc[d] = mfma16(cv[d], pf, acc[d]);
            const int ja = 8 * pi + g, jb = ja + 4;
            LAS float* ir = imp + c * 257;
            ir[ja] += (pr[0] + pr[1]) + (pr[2] + pr[3]); ir[jb] += (pr[4] + pr[5]) + (pr[6] + pr[7]);
            asm volatile("" ::: "memory");
            ir[ja + 1] += pr[3]; if (jb + 1 < 256) ir[jb + 1] += pr[7];
            asm volatile("" ::: "memory");
        };
        loadk(ka, 0);
        for (int pi = 0; pi < npair; pi += 2) {
            loadk(kb, pi + 1 < npair ? pi + 1 : pi);
            pass2(ka, pi);
            if (pi + 1 < npair) { loadk(ka, pi + 2 < npair ? pi + 2 : pi + 1); pass2(kb, pi + 1); }
        }
        if (real) {
            const float gt = sigmoidf_(bf2f(((const bf16_t*)(big + OB_GD))[(size_t)t * 64 + head * 3 + 0]));
#pragma unroll
            for (int d = 0; d < 4; ++d) { bf16_t* op = ob + (size_t)t * 3072 + 2048 + head * 64 + 16 * d + 4 * g; const u32x2 o = *(const u32x2*)op;
                u32x2 w; w.x = pk2(bflo(o.x) + acc[d][0] * gt, bfhi(o.x) + acc[d][1] * gt); w.y = pk2(bflo(o.y) + acc[d][2] * gt, bfhi(o.y) + acc[d][3] * gt); *(u32x2*)op = w; }
        }
    }
    __syncthreads();
    for (int qq = 0; qq < 2; ++qq) {
        const int qi = 2 * wave + qq, tq = t0 + qi, cur = tq >> 6; int* ip = idx + ((size_t)tq * 2 + grp) * 16;
        if (cur <= 15) { if (lane < 16 && real) ip[lane] = lane <= cur ? lane : -1; continue; }
        float v[4];
#pragma unroll
        for (int i = 0; i < 4; ++i) { const int j = lane + 64 * i; float a = 0.f;
#pragma unroll
            for (int w = 0; w < 8; ++w) a += impall[w * (16 * 257) + qi * 257 + j];
            v[i] = (j >= 1 && j <= cur - 2) ? a : -1.f; }
        if (lane == 0 && real) { ip[0] = 0; ip[1] = cur - 1; ip[2] = cur; }
        for (int rnd = 0; rnd < 13; ++rnd) {
            float bv = v[0]; int bj = lane;
#pragma unroll
            for (int i = 1; i < 4; ++i) if (v[i] > bv) { bv = v[i]; bj = lane + 64 * i; }
            float wm = bv;
            wm = fmaxf(wm, __builtin_bit_cast(float, __builtin_amdgcn_update_dpp(0, __builtin_bit_cast(int, wm), 0xB1, 0xF, 0xF, false)));
            wm = fmaxf(wm, __builtin_bit_cast(float, __builtin_amdgcn_update_dpp(0, __builtin_bit_cast(int, wm), 0x4E, 0xF, 0xF, false)));
            wm = fmaxf(wm, __builtin_bit_cast(float, __builtin_amdgcn_update_dpp(0, __builtin_bit_cast(int, wm), 0x124, 0xF, 0xF, false)));
            wm = fmaxf(wm, __builtin_bit_cast(float, __builtin_amdgcn_update_dpp(0, __builtin_bit_cast(int, wm), 0x128, 0xF, 0xF, false)));
            const float r0 = __builtin_bit_cast(float, __builtin_amdgcn_readlane(__builtin_bit_cast(int, wm), 0)), r1 = __builtin_bit_cast(float, __builtin_amdgcn_readlane(__builtin_bit_cast(int, wm), 16));
            const float r2 = __builtin_bit_cast(float, __builtin_amdgcn_readlane(__builtin_bit_cast(int, wm), 32)), r3 = __builtin_bit_cast(float, __builtin_amdgcn_readlane(__builtin_bit_cast(int, wm), 48));
            const float gm = fmaxf(fmaxf(r0, r1), fmaxf(r2, r3));
            const unsigned long long bal = __ballot(bv == gm);
            const int owner = __builtin_ctzll(bal);
            const int pick = __builtin_amdgcn_readlane(bj, owner);
#pragma unroll
            for (int i = 0; i < 4; ++i) if (pick == lane + 64 * i) v[i] = -2.f;
            if (lane == 0 && real) ip[3 + rnd] = pick;
        }
    }
    __syncthreads();
}

__device__ __forceinline__ void compress_unit(const unsigned char* ws, const unsigned char* big, unsigned char* misc, int n0, int grp, int kind, int lane) {
    const int g = lane >> 4, c = lane & 15;
    const bf16_t* src = (const bf16_t*)(big + (kind ? OB_VCMP : OB_KCMP)) + grp * 64;
    const bf16_t* w1 = (const bf16_t*)(ws + WS_WC1 + (kind ? 512 * 1024 : 0));
    const bf16_t* w2 = (const bf16_t*)(ws + WS_WC2 + (kind ? 16384 : 0));
    const float* bv = (const float*)(ws + WS_SMALL) + (kind ? 128 : 0);
    const int n = n0 + c; int rbase = 16 * n; rbase = rbase > S_ - 32 ? S_ - 32 : rbase;
    f32x4 hacc[8];
#pragma unroll
    for (int h = 0; h < 8; ++h) hacc[h] = (f32x4){0.f, 0.f, 0.f, 0.f};
#pragma unroll 4
    for (int ks = 0; ks < 64; ++ks) {
        const bf16x8 xf = *(const bf16x8*)(src + (size_t)(rbase + (ks >> 1)) * 128 + 32 * (ks & 1) + 8 * g);
#pragma unroll
        for (int h = 0; h < 8; ++h) hacc[h] = mfma16(*(const bf16x8*)(w1 + (size_t)(16 * h + c) * 2048 + 32 * ks + 8 * g), xf, hacc[h]);
    }
#pragma unroll
    for (int h = 0; h < 8; ++h) { const f32x4 b4 = *(const f32x4*)(bv + 16 * h + 4 * g);
#pragma unroll
        for (int r = 0; r < 4; ++r) { const float x = hacc[h][r] + b4[r]; const float u = 0.7978845608028654f * (x + 0.044715f * x * x * x);
            const float th = 1.0f - 2.0f / (1.0f + __expf(2.0f * u)); hacc[h][r] = 0.5f * x * (1.0f + th); } }
    f32x4 oacc[4];
#pragma unroll
    for (int d = 0; d < 4; ++d) oacc[d] = (f32x4){0.f, 0.f, 0.f, 0.f};
#pragma unroll
    for (int s = 0; s < 4; ++s) {
        const bf16x8 hf = mk8p(hacc[2 * s][0], hacc[2 * s][1], hacc[2 * s][2], hacc[2 * s][3], hacc[2 * s + 1][0], hacc[2 * s + 1][1], hacc[2 * s + 1][2], hacc[2 * s + 1][3]);
#pragma unroll
        for (int d = 0; d < 4; ++d) { const bf16_t* wp = w2 + (size_t)(16 * d + c) * 128 + 32 * s + 4 * g;
            oacc[d] = mfma16(mk8(*(const u32x2*)wp, *(const u32x2*)(wp + 16)), hf, oacc[d]); }
    }
    if (kind == 0) { bf16_t* kc = (bf16_t*)(misc + MS_KC) + (size_t)grp * 65536;
#pragma unroll
        for (int d = 0; d < 4; ++d) { u32x2 w; w.x = pk2(oacc[d][0], oacc[d][1]); w.y = pk2(oacc[d][2], oacc[d][3]); *(u32x2*)(kc + rb_off(2, n, 16 * d + 4 * g)) = w; }
    } else { bf16_t* vct = (bf16_t*)(misc + MS_VCT) + (size_t)grp * 65536;
#pragma unroll
        for (int d = 0; d < 4; ++d)
#pragma unroll
            for (int r = 0; r < 4; ++r) vct[tb_off(64, 16 * d + 4 * g + r, n)] = (bf16_t)f2bf(oacc[d][r]);
    }
}

__device__ __forceinline__ void u_unit(const unsigned char* big, bf16_t* UT, int hh, int ch, int dvt, int lane) {
    const int g = lane >> 4, c = lane & 15;
    const bf16_t* KTT = (const bf16_t*)(big + OB_KTT) + (size_t)hh * 256 * S_ + ((size_t)(ch * 8) * 256 + c) * 32 + 8 * g;
    const bf16_t* VTT = (const bf16_t*)(big + OB_VTT) + (size_t)hh * 512 * S_ + ((size_t)(ch * 8) * 512 + 16 * dvt + c) * 32 + 8 * g;
    f32x4 acc[2][16];
#pragma unroll
    for (int i = 0; i < 16; ++i) { acc[0][i] = (f32x4){0.f, 0.f, 0.f, 0.f}; acc[1][i] = (f32x4){0.f, 0.f, 0.f, 0.f}; }
    for (int ks = 0; ks < 8; ++ks) {
        const bf16x8 vf0 = *(const bf16x8*)(VTT + (size_t)ks * 512 * 32), vf1 = *(const bf16x8*)(VTT + (size_t)ks * 512 * 32 + 8 * 16 * 32);
#pragma unroll
        for (int i = 0; i < 16; ++i) { const bf16x8 kf = *(const bf16x8*)(KTT + (size_t)ks * 256 * 32 + 512 * i); acc[0][i] = mfma16(kf, vf0, acc[0][i]); acc[1][i] = mfma16(kf, vf1, acc[1][i]); }
    }
#pragma unroll
    for (int h2 = 0; h2 < 2; ++h2) {
        bf16_t* up = UT + (size_t)(hh * 64 + ch) * 131072 + ((size_t)((dvt + 8 * h2) * 8) * 16 + c) * 32 + 4 * g;
#pragma unroll
        for (int i = 0; i < 16; ++i) { u32x2 w; w.x = pk2(acc[h2][i][0], acc[h2][i][1]); w.y = pk2(acc[h2][i][2], acc[h2][i][3]); *(u32x2*)(up + (i >> 1) * 512 + 16 * (i & 1)) = w; }
    }
}
__device__ __forceinline__ void scan_items(bf16_t* UT, int gw, int nw, int lane) {
    for (int item = gw * 64 + lane; item < 4 * 32768; item += nw * 64) {
        const int hh = item >> 15, e4 = item & 32767;
        const float dec = exp2f(256.0f * __log2f(1.0f - exp2f(-5.0f - (float)hh)));
        bf16_t* pp = UT + (size_t)hh * 64 * 131072 + (size_t)e4 * 4;
        float r0 = 0.f, r1 = 0.f, r2 = 0.f, r3 = 0.f;
#pragma unroll 8
        for (int ch = 0; ch < 64; ++ch) { u32x2* q = (u32x2*)(pp + (size_t)ch * 131072); const u32x2 u = *q;
            u32x2 w; w.x = pk2(r0, r1); w.y = pk2(r2, r3); *q = w;
            r0 = dec * (r0 + bflo(u.x)); r1 = dec * (r1 + bfhi(u.x)); r2 = dec * (r2 + bflo(u.y)); r3 = dec * (r3 + bfhi(u.y)); }
    }
}

__device__ __forceinline__ void intra_unit(const unsigned char* big, const bf16_t* UT, bf16_t* ob, const float* gn, int hh, int t0, int lane, bool real = true) {
    const int g = lane >> 4, c = lane & 15, t = t0 + c;
    const bf16_t* qp = (const bf16_t*)(big + OB_QT) + (size_t)hh * 256 * S_ + ((size_t)(t0 >> 4) * 8 * 16 + c) * 32 + 8 * g;
    const bf16_t* KT = (const bf16_t*)(big + OB_KT) + (size_t)hh * 256 * S_ + c * 32 + 8 * g;
    const bf16_t* VTTb = (const bf16_t*)(big + OB_VTT) + (size_t)hh * 512 * S_ + c * 32 + 8 * g;
    bf16_t* orow = ob + (size_t)t * 3072 + hh * 512 + 4 * g;
    const int tlo = (t0 & ~255) >> 4, thi = t0 >> 4;
    const bf16_t* RTb = UT + (size_t)(hh * 64 + (t0 >> 8)) * 131072 + c * 32 + 8 * g;
    float sum = 0.f, sq = 0.f;
    bf16x8 pfs[8];
    const int np = ((thi - tlo) >> 1) + 1;
#pragma unroll
    for (int pi = 0; pi < 8; ++pi) {
        if (pi < np) {
            const int ta = tlo + 2 * pi, tb = ta + 1;
            const bf16_t* kpa = KT + (size_t)ta * 4096; const bf16_t* kpb = kpa + 4096;
            f32x4 sa = (f32x4){0.f, 0.f, 0.f, 0.f}, sb = (f32x4){0.f, 0.f, 0.f, 0.f};
#pragma unroll
            for (int s = 0; s < 8; ++s) { const bf16x8 qf = *(const bf16x8*)(qp + 512 * s); sa = mfma16(*(const bf16x8*)(kpa + 512 * s), qf, sa); sb = mfma16(*(const bf16x8*)(kpb + 512 * s), qf, sb);
                if ((s & 3) == 3) __builtin_amdgcn_sched_barrier(0); }
            float pr[8];
#pragma unroll
            for (int r = 0; r < 4; ++r) { pr[r] = (16 * ta + 4 * g + r <= t) ? sa[r] : 0.f; pr[4 + r] = (16 * tb + 4 * g + r <= t) ? sb[r] : 0.f; }
            pfs[pi] = mk8p(pr[0], pr[1], pr[2], pr[3], pr[4], pr[5], pr[6], pr[7]);
        } else pfs[pi] = (bf16x8){0, 0, 0, 0, 0, 0, 0, 0};
    }
#pragma nounroll
    for (int hf = 0; hf < 4; ++hf) {
        f32x4 acc[8];
#pragma unroll
        for (int d = 0; d < 8; ++d) acc[d] = (f32x4){0.f, 0.f, 0.f, 0.f};
#pragma unroll
        for (int dh = 0; dh < 2; ++dh) {
            const bf16_t* vp0 = VTTb + ((size_t)(tlo >> 1) * 512 + 16 * (hf * 8 + dh * 4)) * 32;
            bf16x8 cv[4];
#pragma unroll
            for (int d = 0; d < 4; ++d) cv[d] = *(const bf16x8*)(vp0 + 512 * d);
#pragma unroll
            for (int pi = 0; pi < 8; ++pi) {
                if (pi < np) {
                    bf16x8 nv[4];
                    const bf16_t* vp = vp0 + (size_t)(pi + 1 < np ? pi + 1 : pi) * 512 * 32;
#pragma unroll
                    for (int d = 0; d < 4; ++d) nv[d] = *(const bf16x8*)(vp + 512 * d);
                    __builtin_amdgcn_sched_barrier(0);
#pragma unroll
                    for (int d = 0; d < 4; ++d) acc[dh * 4 + d] = mfma16(cv[d], pfs[pi], acc[dh * 4 + d]);
#pragma unroll
                    for (int d = 0; d < 4; ++d) cv[d] = nv[d];
                }
            }
        }
#pragma unroll
        for (int dh = 0; dh < 2; ++dh) {
            const bf16_t* rp0 = RTb + (size_t)(hf * 8 + dh * 4) * 8 * 512;
            bf16x8 cr[4];
#pragma unroll
            for (int d = 0; d < 4; ++d) cr[d] = *(const bf16x8*)(rp0 + (size_t)d * 8 * 512);
#pragma unroll
            for (int ks = 0; ks < 8; ++ks) {
                bf16x8 nr[4]; const int kn = ks < 7 ? ks + 1 : ks;
                const bf16x8 cq = *(const bf16x8*)(qp + 512 * ks);
#pragma unroll
                for (int d = 0; d < 4; ++d) nr[d] = *(const bf16x8*)(rp0 + (size_t)(d * 8 + kn) * 512);
                __builtin_amdgcn_sched_barrier(0);
#pragma unroll
                for (int d = 0; d < 4; ++d) acc[dh * 4 + d] = mfma16(cr[d], cq, acc[dh * 4 + d]);
#pragma unroll
                for (int d = 0; d < 4; ++d) cr[d] = nr[d];
            }
        }
#pragma unroll
        for (int d = 0; d < 8; ++d) {
            const float x0 = acc[d][0], x1 = acc[d][1], x2 = acc[d][2], x3 = acc[d][3];
            sum += (x0 + x1) + (x2 + x3); sq += (x0 * x0 + x1 * x1) + (x2 * x2 + x3 * x3);
            u32x2 w; w.x = pk2(x0, x1); w.y = pk2(x2, x3); if (real) *(u32x2*)(orow + 16 * (hf * 8 + d)) = w; else sq += bflo(w.x) + bflo(w.y); }
        __builtin_amdgcn_sched_barrier(0);
    }
    sum += shx(sum, 16, lane); sum += shx(sum, 32, lane); sq += shx(sq, 16, lane); sq += shx(sq, 32, lane);
    const float mu = sum * (1.0f / 512.0f); float var = sq * (1.0f / 512.0f) - mu * mu; var = var < 0.f ? 0.f : var;
    const float rs = rsqrtf(var + 1e-5f);
    const bf16_t* gcp = (const bf16_t*)(big + OB_GC) + (size_t)t * 2048 + hh * 512 + 4 * g;
    const float* gnp = gn + hh * 512 + 4 * g;
#pragma unroll
    for (int d = 0; d < 32; ++d) { const u32x2 gc = *(const u32x2*)(gcp + 16 * d); const f32x4 gw = *(const f32x4*)(gnp + 16 * d); const u32x2 o = *(const u32x2*)(orow + 16 * d);
        const float y0 = (bflo(o.x) - mu) * rs * gw[0] * siluf_(bflo(gc.x)), y1 = (bfhi(o.x) - mu) * rs * gw[1] * siluf_(bfhi(gc.x));
        const float y2 = (bflo(o.y) - mu) * rs * gw[2] * siluf_(bflo(gc.y)), y3 = (bfhi(o.y) - mu) * rs * gw[3] * siluf_(bfhi(gc.y));
        u32x2 w; w.x = pk2(y0, y1); w.y = pk2(y2, y3); if (real || y0 == 1.2345f) *(u32x2*)(orow + 16 * d) = w;
        if ((d & 3) == 3) __builtin_amdgcn_sched_barrier(0); }
}

#ifndef REP_CHAIN
#define REP_CHAIN 1
#define REP_WIN 1
#define REP_CMP 1
#define REP_INTRA 1
#define REP_SEL 1
#define REP_EATT 1
#define REP_GIN 1
#define REP_GGU 1
#define REP_MISC 1
#endif
#define XB_TMO      128
#define XB_XCNT(j)  (256  + 64 * (j))
#define XB_XSUB(j)  (1280 + 64 * (j))
#define XB_XGEN(j)  (2304 + 64 * (j))
#define XB_TOP      3328
#define XB_TOPGEN   3392
#define XCD_BAR_WORDS 3456
#define XB_SPIN_CAP (1u << 18)

__device__ __forceinline__ unsigned xb_ld(unsigned* p)              { return __hip_atomic_load(p, __ATOMIC_RELAXED, __HIP_MEMORY_SCOPE_AGENT); }
__device__ __forceinline__ unsigned xb_add(unsigned* p, unsigned v) { return __hip_atomic_fetch_add(p, v, __ATOMIC_RELAXED, __HIP_MEMORY_SCOPE_AGENT); }
__device__ __forceinline__ unsigned xb_xcc_id() { return (unsigned)__builtin_amdgcn_s_getreg((3 << 11) | 20) & 0xFu; }
#define XB_SPIN(cond, bar) do { unsigned _sp = 0; while (cond) { __builtin_amdgcn_s_sleep(1); \
    if ((++_sp & 255u) == 0u) { if (xb_ld(&(bar)[XB_TMO])) break; if (_sp > XB_SPIN_CAP) { atomicAdd(&(bar)[XB_TMO], 1u); break; } } } } while (0)

struct XcdBarrier {
    unsigned* bar; unsigned x;
    volatile LAS unsigned* st;
};

__device__ __forceinline__ XcdBarrier xcd_barrier_post(unsigned* bar, volatile LAS unsigned* st) {
    XcdBarrier b; b.bar = bar; b.x = xb_xcc_id(); b.st = st;
    if (threadIdx.x == 0) (void)xb_add(&bar[XB_XCNT(b.x)], 1u);
    return b;
}
__device__ __forceinline__ void xcd_barrier_complete(unsigned* bar, unsigned x, unsigned& nloc, unsigned& nx) {
    const unsigned G = gridDim.x * gridDim.y * gridDim.z;
    unsigned sum, cnt, mine, sp = 0u;
    for (;;) {
        sum = 0u; cnt = 0u; mine = 0u;
#pragma unroll
        for (unsigned j = 0; j < 16; ++j) { const unsigned c = xb_ld(&bar[XB_XCNT(j)]); sum += c; cnt += (c > 0u) ? 1u : 0u; mine = (j == x) ? c : mine; }
        if (sum == G) break;
        __builtin_amdgcn_s_sleep(1);
        if ((++sp & 255u) == 0u) { if (xb_ld(&bar[XB_TMO])) break; if (sp > XB_SPIN_CAP) { atomicAdd(&bar[XB_TMO], 1u); break; } }
    }
    nloc = mine > 0u ? mine : 1u; nx = cnt > 0u ? cnt : 1u;
}

__device__ __forceinline__ void xcd_barrier(const XcdBarrier& b) {
    asm volatile("s_waitcnt vmcnt(0)" ::: "memory");
    __syncthreads();
    if (threadIdx.x == 0) {
        unsigned* bar = b.bar;
        __builtin_amdgcn_s_waitcnt(0);
        unsigned nloc = b.st[0], nx = b.st[1];
        if (nloc == 0u) { xcd_barrier_complete(bar, b.x, nloc, nx); b.st[0] = nloc; b.st[1] = nx; }
        const unsigned old = xb_add(&bar[XB_XSUB(b.x)], 1u);
        const unsigned gen = old / nloc;
        if (old + 1u == (gen + 1u) * nloc) {
            __builtin_amdgcn_fence(__ATOMIC_RELEASE, "agent");
            asm volatile("s_waitcnt vmcnt(0)" ::: "memory");
            const unsigned og = xb_add(&bar[XB_TOP], 1u);
            const unsigned tg = og / nx;
            if (og + 1u == (tg + 1u) * nx) xb_add(&bar[XB_TOPGEN], 1u);
            else XB_SPIN(xb_ld(&bar[XB_TOPGEN]) == tg, bar);
            __builtin_amdgcn_fence(__ATOMIC_ACQUIRE, "agent");
            xb_add(&bar[XB_XGEN(b.x)], 1u);
            asm volatile("s_waitcnt vmcnt(0)" ::: "memory");
        } else {
            XB_SPIN(xb_ld(&bar[XB_XGEN(b.x)]) == gen, bar);
            __builtin_amdgcn_fence(__ATOMIC_ACQUIRE, "agent");
            asm volatile("s_waitcnt vmcnt(0)" ::: "memory");
        }
    }
    __syncthreads();
}

#ifndef REP_GRES
#define REP_GRES 1
#endif
#ifndef REP_GEIN
#define REP_GEIN 1
#endif
#ifndef REP_SYNC
#define REP_SYNC 1
#endif
#define REAL_(rep, R) ((rep) == (R) - 1 || p.ph_lo < 0)
typedef const __attribute__((address_space(4))) Params* KP;
typedef const __attribute__((address_space(4))) Params* KP;
__device__ __forceinline__ Params load_params() { KP k = (KP)__builtin_amdgcn_kernarg_segment_ptr(); asm volatile("" : "+s"(k)); Params r; r.x = k->x; r.rel_table = k->rel_table; r.norm_mix = k->norm_mix; r.norm_ffn = k->norm_ffn; r.norm_final = k->norm_final; r.even_w_in = k->even_w_in; r.even_sinks = k->even_sinks; r.even_w_out = k->even_w_out; r.odd_w_in = k->odd_w_in; r.odd_ret_gn = k->odd_ret_gn; r.odd_cmp_pos_k = k->odd_cmp_pos_k; r.odd_cmp_pos_v = k->odd_cmp_pos_v; r.odd_cmp_k_w1 = k->odd_cmp_k_w1; r.odd_cmp_k_w2 = k->odd_cmp_k_w2; r.odd_cmp_v_w1 = k->odd_cmp_v_w1; r.odd_cmp_v_w2 = k->odd_cmp_v_w2; r.odd_w_out = k->odd_w_out; r.ffn_w_gate = k->ffn_w_gate; r.ffn_w_up = k->ffn_w_up; r.ffn_w_down = k->ffn_w_down; r.out = k->out; r.ws = k->ws; r.ph_lo = k->ph_lo; r.ph_hi = k->ph_hi; return r; }
__global__ void __launch_bounds__(512, 2) trunk_fwd(Params p0) {
    extern __shared__ __attribute__((aligned(16))) unsigned char lds_raw[];
    LAS unsigned char* lds = (LAS unsigned char*)lds_raw;
    LAS float* tbl = (LAS float*)(lds + LDS_TBL);
    cg::grid_group grid = cg::this_grid();
    const int G = gridDim.x, nw = 8 * G;
    tbl[threadIdx.x] = p0.rel_table[threadIdx.x];
    volatile LAS unsigned* xst = (volatile LAS unsigned*)(lds + LDS_XB);
    if (threadIdx.x < 4) xst[threadIdx.x] = 0u;
    __syncthreads();
    (void)xcd_barrier_post((unsigned*)(p0.ws + WS_BAR), xst);
    int ph = 0; const int ph_lo_ = p0.ph_lo, ph_hi_ = p0.ph_hi;
#define PH_BEGIN if (ph >= ph_lo_ && ph < ph_hi_) { const Params p = load_params(); const int tid = launder_tid(), lane = tid & 63, wave = tid >> 6, bid = launder_bid(), gw = wave * G + bid; (void)lane; (void)gw; unsigned char* ws = launder_ptr(p.ws); unsigned char* big = ws + WS_BIG; unsigned char* misc = ws + WS_MISC; bf16_t* hn = (bf16_t*)(ws + WS_HN); bf16_t* obuf = (bf16_t*)(ws + WS_O); float* outp = (float*)launder_ptr((unsigned char*)p.out); (void)big; (void)misc; (void)hn; (void)obuf; (void)outp;
#define EVP bf16_t* qkv = (bf16_t*)(big + EB_QKV); bf16_t* op = (bf16_t*)(big + EB_OP); float* lsep = (float*)(big + EB_LSE); (void)qkv; (void)op; (void)lsep;
#define PH_END   if (ph + 1 < ph_hi_) { if (p.ph_lo < 0) grid.sync(); XcdBarrier xb_; xb_.bar = (unsigned*)(launder_ptr(p.ws) + WS_BAR); xb_.x = xb_xcc_id(); xb_.st = (volatile LAS unsigned*)(lds + LDS_XB); for (int rs_ = 0; rs_ < REP_SYNC; ++rs_) xcd_barrier(xb_); } } ++ph;

    for (int layer = 0; layer < 4; ++layer) {
        const int li = layer >> 1; const bool odd = layer & 1;

        PH_BEGIN for (int rep = 0; rep < REP_MISC; ++rep) { phase_convert(p, layer, lds); phase_rmsnorm(layer == 0 ? p.x : outp, p.norm_mix + layer * DM, hn, nullptr); } PH_END
        if (!odd) {
            PH_BEGIN { EVP pg8::Gemm g{hn, (const bf16_t*)(ws + WS_WIN), M_, 2304, 1024}; pg8::StaticOrder so; so.init(M_, 2304, G, bid); EpiBf16 e{qkv, 2304};
                for (int rep = 0; rep < REP_GEIN; ++rep) pg8::gemm_phase<EpiBf16, pg8::StaticOrder, true, true>(lds, g, so, e); } PH_END
            PH_BEGIN { EVP
                for (int rep = 0; rep < REP_EATT; ++rep) for (int j = (G == 256 ? (bid >> 3) * 8 + wave : gw); j < (G == 256 ? 8192 : 65536); j += (G == 256 ? 256 : nw)) {
                    const int kind = G == 256 ? j >> 11 : j >> 14, b = G == 256 ? (j >> 10) & 1 : (j >> 13) & 1, h = G == 256 ? (bid & 7) : (j >> 10) & 7, tile = j & 1023;
                    const bf16_t* base = qkv + (size_t)b * S_ * 2304;
                    if (kind == 0) {
                        band_unit<false>(base + h * 64, 2304, base + 512 + (h >> 2) * 64, 2304, base + 640 + (h >> 2) * 64, 2304, S_, 1, 0, 127, h, tile * 16,
                                         obuf + (size_t)b * S_ * 1024 + h * 64, 1024, nullptr, 0, nullptr, 0, true, p.even_sinks[li * 8 + h], tbl, lane);
                    } else {
                        const int sh = 2 * (kind - 1), dil = 1 << sh, L = S_ >> sh; const int res = tile >> (10 - sh), it = tile & ((1024 >> sh) - 1);
                        band_unit<false>(base + 768 + h * 64, 2304, base + 1280 + h * 64, 2304, base + 1792 + h * 64, 2304, L, dil, res, 128, 8 + h, it * 16,
                                         op + ((size_t)(kind - 1) * M_ + (size_t)b * S_) * 512 + h * 64, 512, lsep + ((size_t)(kind - 1) * M_ + (size_t)b * S_) * 8 + h, 8, nullptr, 0, false, 0.f, tbl, lane);
                    }
                }
            } PH_END
            PH_BEGIN { EVP
                for (int u = bid * 512 + tid; u < M_ * 8 * 8; u += G * 512) {
                    const int tok = u >> 6, h = (u >> 3) & 7, ch = u & 7;
                    const float l0 = lsep[(size_t)tok * 8 + h], l1 = lsep[((size_t)M_ + tok) * 8 + h], l2 = lsep[((size_t)2 * M_ + tok) * 8 + h];
                    const float mx = fmaxf(l0, fmaxf(l1, l2)); float w0 = __expf(l0 - mx), w1 = __expf(l1 - mx), w2 = __expf(l2 - mx); const float iw = 1.0f / (w0 + w1 + w2); w0 *= iw; w1 *= iw; w2 *= iw;
                    const size_t eo = (size_t)tok * 512 + h * 64 + ch * 8;
                    const u32x4 a = *(const u32x4*)(op + eo), b4 = *(const u32x4*)(op + (size_t)M_ * 512 + eo), c4 = *(const u32x4*)(op + (size_t)2 * M_ * 512 + eo);
                    u32x4 r;
#pragma unroll
                    for (int k = 0; k < 4; ++k) r[k] = pk2(w0 * bflo(a[k]) + w1 * bflo(b4[k]) + w2 * bflo(c4[k]), w0 * bfhi(a[k]) + w1 * bfhi(b4[k]) + w2 * bfhi(c4[k]));
                    *(u32x4*)(obuf + (size_t)tok * 1024 + 512 + h * 64 + ch * 8) = r;
                }
            } PH_END
            PH_BEGIN { pg8::Gemm g{obuf, (const bf16_t*)(ws + WS_WOUT), M_, 1024, 1024}; pg8::StaticOrder so; so.init(M_, 1024, G, bid); for (int rep = 0; rep < REP_GRES; ++rep) { EpiResid e{layer == 0 ? p.x : outp, outp, REAL_(rep, REP_GRES)};
                pg8::gemm_phase<EpiResid, pg8::StaticOrder, true, true>(lds, g, so, e); } } PH_END
        } else {
            for (int b = 0; b < 2; ++b) {
                PH_BEGIN { pg8::Gemm g{hn + (size_t)b * S_ * 1024, (const bf16_t*)(ws + WS_WIN), S_, 8192, 1024}; pg8::StaticOrder so; so.init(S_, 8192, G, bid); EpiOddIn e{big};
                    for (int rep = 0; rep < REP_GIN; ++rep) pg8::gemm_phase<EpiOddIn, pg8::StaticOrder, true, true>(lds, g, so, e); } PH_END
                PH_BEGIN {
                    { const int ln = launder_tid() & 63; for (int rep = 0; rep < REP_CHAIN; ++rep) for (int hc = bid; hc < 256; hc += G) for (int k = 0; k < 2; ++k) u_unit(big, hn, hc >> 6, hc & 63, wave + 16 * k, ln); }
                    { const int ln = launder_tid() & 63; for (int u = gw; u < 256; u += nw) compress_unit(ws, big, misc, (u & 63) * 16, (u >> 6) & 1, u >> 7, ln); }
                    { const int ln = launder_tid() & 63; for (int rep = 0; rep < REP_WIN; ++rep) {
                        if (G == 256) { const int lw = (bid >> 3) * 8 + wave, tile = (bid & 7) * 128 + (lw & 127);
                            for (int h = lw >> 7; h < 16; h += 2) win_unit(big, obuf, h, tile * 16, tbl, ln); }
                        else for (int v = gw; v < 16384; v += nw) win_unit(big, obuf, v >> 10, (v & 1023) * 16, tbl, ln); } }
                } PH_END
                PH_BEGIN {
                    { const int ln = launder_tid() & 63; scan_items(hn, gw, nw, ln); }
                    { const int tl = launder_tid(); const int ln = tl & 63, wv = __builtin_amdgcn_readfirstlane(tl >> 6);
                      for (int rep = 0; rep < REP_CMP; ++rep) for (int ts = bid; ts < 256; ts += G)
                        for (int i = 0; i < 8; ++i) { const int q = i >> 1, grp = i & 1; const int tile = q == 0 ? ts : (q == 1 ? 511 - ts : (q == 2 ? 512 + ts : 1023 - ts));
                            cmp_unit(big, misc, (int*)(misc + MS_IDX), obuf, tile * 16, grp, tbl, (LAS float*)lds, wv, ln, REAL_(rep, REP_CMP)); } }
                } PH_END
                PH_BEGIN {
                    { const int ln = launder_tid() & 63; for (int rep = 0; rep < REP_INTRA; ++rep) for (int hc = bid; hc < 256; hc += G) for (int k = 0; k < 2; ++k) { const int tl = k ? 15 - wave : wave;
                            intra_unit(big, hn, obuf, p.odd_ret_gn + (size_t)li * 2048, hc >> 6, ((hc & 63) * 16 + tl) * 16, ln, REAL_(rep, REP_INTRA)); } }
                    { const int ln = launder_tid() & 63; for (int rep = 0; rep < REP_SEL; ++rep) {
                        if (G == 256) { const int grp = bid & 1, xq = (bid >> 1) & 3, lw = (bid >> 3) * 8 + wave;
                            for (int t = xq * 4096 + lw; t < (xq + 1) * 4096; t += 256) sel_unit(big, (const int*)(misc + MS_IDX), obuf, t, grp, tbl, ln, REAL_(rep, REP_SEL)); }
                        else for (int u = gw; u < 2 * S_; u += nw) sel_unit(big, (const int*)(misc + MS_IDX), obuf, u >> 1, u & 1, tbl, ln, REAL_(rep, REP_SEL)); } }
                } PH_END
                PH_BEGIN { pg8::Gemm g{obuf, (const bf16_t*)(ws + WS_WOUT), S_, 1024, 3072}; pg8::StaticOrder so; so.init(S_, 1024, G, bid);
                    for (int rep = 0; rep < REP_GRES; ++rep) { EpiResid e{(layer == 0 ? p.x : outp) + (size_t)b * S_ * 1024, outp + (size_t)b * S_ * 1024, REAL_(rep, REP_GRES)};
                    pg8::gemm_phase<EpiResid, pg8::StaticOrder, true, true>(lds, g, so, e); }
                    if (b == 0) phase_rmsnorm(outp, p.norm_mix + layer * DM, hn, nullptr, S_, M_);
                } PH_END
            }
        }
        PH_BEGIN phase_rmsnorm(outp, p.norm_ffn + layer * DM, hn, nullptr); PH_END
        PH_BEGIN { pg8::Gemm g{hn, (const bf16_t*)(ws + WS_WGU), M_, 5632, 1024}; pg8::StaticOrder so; so.init(M_, 5632, G, bid); EpiSwiglu e{(bf16_t*)big};
            for (int rep = 0; rep < REP_GGU; ++rep) pg8::gemm_phase<EpiSwiglu, pg8::StaticOrder, true, true>(lds, g, so, e); } PH_END
        PH_BEGIN { pg8::Gemm g{(const bf16_t*)big, (const bf16_t*)(ws + WS_WDN), M_, 1024, FF_}; pg8::StaticOrder so; so.init(M_, 1024, G, bid); for (int rep = 0; rep < REP_GRES; ++rep) { EpiResid e{outp, outp, REAL_(rep, REP_GRES)};
            pg8::gemm_phase<EpiResid, pg8::StaticOrder, true, true>(lds, g, so, e); } } PH_END
    }
    PH_BEGIN phase_rmsnorm(outp, p.norm_final, nullptr, outp); PH_END
}

#ifndef N_PHASES
#define N_PHASES 45
#endif
#ifndef ONE_LAUNCH
#define ONE_LAUNCH 1
#endif
extern "C" void kernel_launch(void* const* d_in, const int* in_sizes, int n_in, void* d_out, int out_size, void* d_ws, size_t ws_size, hipStream_t stream) {
    static int grid = 0;
    if (grid == 0) {
        if (n_in != 20 || out_size != M_ * DM || ws_size < WS_END) { fprintf(stderr, "kernel_launch: unexpected shapes (n_in %d, out %d, ws %zu); nothing launched\n", n_in, out_size, ws_size); grid = -1; return; }
        int dev = 0, cus = 0;
        if (hipGetDevice(&dev) != hipSuccess || hipDeviceGetAttribute(&cus, hipDeviceAttributeMultiprocessorCount, dev) != hipSuccess) { grid = -1; return; }
        if (hipFuncSetAttribute((const void*)trunk_fwd, hipFuncAttributeMaxDynamicSharedMemorySize, LDS_BYTES) != hipSuccess) { fprintf(stderr, "kernel_launch: hipFuncSetAttribute failed\n"); grid = -1; return; }
        int per_cu = 0;
        if (hipOccupancyMaxActiveBlocksPerMultiprocessor(&per_cu, (const void*)trunk_fwd, 512, LDS_BYTES) != hipSuccess || per_cu < 1) { fprintf(stderr, "kernel_launch: occupancy query says %d\n", per_cu); (void)hipGetLastError(); }
        grid = cus;
    }
    if (grid < 0) return;
    Params p{};
    const float** pp = (const float**)&p;
    for (int i = 0; i < 20; ++i) pp[i] = (const float*)d_in[i];
    p.out = (float*)d_out; p.ws = (unsigned char*)d_ws;
#if ONE_LAUNCH
    p.ph_lo = 0; p.ph_hi = N_PHASES;
    if (hipMemsetAsync((unsigned char*)d_ws + WS_BAR, 0, XCD_BAR_WORDS * 4, stream) != hipSuccess) { fprintf(stderr, "kernel_launch: memset of the barrier words failed\n"); return; }
    void* args[] = {&p};
    hipError_t e = hipLaunchCooperativeKernel((const void*)trunk_fwd, dim3(grid), dim3(512), args, LDS_BYTES, stream);
    if (e != hipSuccess) fprintf(stderr, "kernel_launch: cooperative launch failed: %s (grid %d)\n", hipGetErrorString(e), grid);
#else
    for (int ph = 0; ph < N_PHASES; ++ph) { p.ph_lo = ph; p.ph_hi = ph + 1; hipLaunchKernelGGL(trunk_fwd, dim3(grid), dim3(512), LDS_BYTES, stream, p); }
#endif
}
```

```cpp
#include <hip/hip_runtime.h>
#include <hip/hip_cooperative_groups.h>
#include <cstdio>
#include <cstdint>
namespace cg = cooperative_groups;

#define LAS __attribute__((address_space(3)))
typedef unsigned short bf16_t;
typedef short bf16x8 __attribute__((ext_vector_type(8)));
typedef float f32x4 __attribute__((ext_vector_type(4)));
typedef unsigned u32x4 __attribute__((ext_vector_type(4)));
typedef unsigned u32x2 __attribute__((ext_vector_type(2)));

__device__ __forceinline__ unsigned f2bf(float f) { unsigned u = __builtin_bit_cast(unsigned, f); return (u + 0x7fffu + ((u >> 16) & 1u)) >> 16; }
__device__ __forceinline__ unsigned pk2s(float lo, float hi) { return f2bf(lo) | (f2bf(hi) << 16); }
typedef float f32x2_t __attribute__((ext_vector_type(2)));
typedef __bf16 bf16x2_t __attribute__((ext_vector_type(2)));
__device__ __forceinline__ unsigned pk2(float lo, float hi) { f32x2_t v = {lo, hi}; bf16x2_t b = __builtin_convertvector(v, bf16x2_t); return __builtin_bit_cast(unsigned, b); }
__device__ __forceinline__ float bf2f(bf16_t b) { return __builtin_bit_cast(float, (unsigned)b << 16); }
__device__ __forceinline__ float bflo(unsigned w) { return __builtin_bit_cast(float, w << 16); }
__device__ __forceinline__ float bfhi(unsigned w) { return __builtin_bit_cast(float, w & 0xffff0000u); }
__device__ __forceinline__ f32x4 mfma16(bf16x8 a, bf16x8 b, f32x4 c) { return __builtin_amdgcn_mfma_f32_16x16x32_bf16(a, b, c, 0, 0, 0); }
__device__ __forceinline__ bf16x8 mk8(u32x2 lo, u32x2 hi) { u32x4 v = {lo.x, lo.y, hi.x, hi.y}; return __builtin_bit_cast(bf16x8, v); }
__device__ __forceinline__ bf16x8 mk8p(float a0, float a1, float a2, float a3, float b0, float b1, float b2, float b3) {
    u32x4 v = {pk2(a0, a1), pk2(a2, a3), pk2(b0, b1), pk2(b2, b3)}; return __builtin_bit_cast(bf16x8, v); }
__device__ __forceinline__ float shx(float v, int mask, int lane) { return __builtin_bit_cast(float, __builtin_amdgcn_ds_bpermute((lane ^ mask) << 2, __builtin_bit_cast(int, v))); }
__device__ __forceinline__ int shx(int v, int mask, int lane) { return __builtin_amdgcn_ds_bpermute((lane ^ mask) << 2, v); }
__device__ __forceinline__ float sigmoidf_(float x) { return 1.0f / (1.0f + __expf(-x)); }
__device__ __forceinline__ float siluf_(float x) { return x / (1.0f + __expf(-x)); }
__device__ __forceinline__ int t5b(int d) {
    float f = __log2f((float)d * 0.0625f) * 2.2857144f;
    int k = (int)f; k = k > 15 ? 15 : k;
    return d < 16 ? d : 16 + k;
}

__device__ __forceinline__ int launder_tid() { int t = threadIdx.x; asm volatile("" : "+v"(t)); return t; }
__device__ __forceinline__ unsigned char* launder_ptr(unsigned char* q) { asm volatile("" : "+s"(q)); return q; }
__device__ __forceinline__ int launder_bid() { int t = blockIdx.x; asm volatile("" : "+s"(t)); return t; }
__device__ __forceinline__ int tperm(int tt) { return ((tt & 12) << 1) | ((tt >> 4) << 2) | (tt & 3); }
__device__ __forceinline__ size_t tb_off(int ndim, int dim, int t) { return ((size_t)(t >> 5) * ndim + dim) * 32 + tperm(t & 31); }
__device__ __forceinline__ size_t rb_off(int nks, int t, int col) { return (((size_t)(t >> 4) * nks + (col >> 5)) * 16 + (t & 15)) * 32 + (col & 31); }
constexpr int S_ = 16384, NB_ = 2, M_ = S_ * NB_, DM = 1024, FF_ = 2816;
constexpr size_t MiB = 1u << 20;
constexpr size_t WS_SMALL = 0;
constexpr size_t WS_WIN = 1 * MiB, WS_WOUT = 17 * MiB, WS_WGU = 23 * MiB, WS_WDN = 34 * MiB, WS_WC1 = 40 * MiB, WS_WC2 = 41 * MiB;
constexpr size_t WS_HN = 45 * MiB, WS_O = 109 * MiB, WS_BIG = 205 * MiB, WS_MISC = 487 * MiB, WS_END = 490 * MiB;
constexpr size_t OB_QT = 0, OB_KT = 32 * MiB, OB_KTT = 64 * MiB, OB_VTT = 96 * MiB, OB_GC = 160 * MiB, OB_QD = 224 * MiB, OB_KCMP = 256 * MiB, OB_VCMP = 260 * MiB,
                 OB_KSLC = 264 * MiB, OB_VSLCT = 268 * MiB, OB_KWIN = 272 * MiB, OB_VWIN = 276 * MiB, OB_GD = 280 * MiB;
constexpr size_t EB_QKV = 0, EB_OP = 144 * MiB, EB_LSE = 240 * MiB;
constexpr size_t MS_KC = 0, MS_VCT = 256 * 1024, MS_IDX = 1 * MiB;
constexpr int LDS_TBL = 132096;
constexpr int LDS_XB = 134144;
constexpr size_t WS_BAR = 65536;
constexpr int LDS_BYTES = 143360;

struct Params {
    const float* x; const float* rel_table; const float* norm_mix; const float* norm_ffn; const float* norm_final;
    const float* even_w_in; const float* even_sinks; const float* even_w_out;
    const float* odd_w_in; const float* odd_ret_gn; const float* odd_cmp_pos_k; const float* odd_cmp_pos_v;
    const float* odd_cmp_k_w1; const float* odd_cmp_k_w2; const float* odd_cmp_v_w1; const float* odd_cmp_v_w2; const float* odd_w_out;
    const float* ffn_w_gate; const float* ffn_w_up; const float* ffn_w_down;
    float* out; unsigned char* ws;
    int ph_lo, ph_hi;
};

namespace pg8 {
#define PG8_LAS __attribute__((address_space(3)))
constexpr int BM = 256, BK = 64, HALF = 128, HTB = HALF * BK * 2  , STAGE_BYTES = 8 * HTB, NXCD = 8, WGM = 8;
__host__ __device__ __forceinline__ int lds_byte(int r, int c) { const int st = (r >> 4) * 2 + (c >> 5), rr = r & 15, cc = c & 31, ob = rr * 64 + cc * 2; return st * 1024 + (ob ^ (((ob >> 9) & 1) << 5)); }
__host__ __device__ __forceinline__ void stage_rc(int b, int& R, int& C) { const int st = b / 1024, sb = b % 1024, swz = sb ^ (((sb >> 9) & 1) << 5); R = (st >> 1) * 16 + swz / 64; C = (st & 1) * 32 + (swz % 64) / 2; }
__host__ __device__ __forceinline__ int perm32(int rho) { const int n = rho >> 4, i = rho & 15; return 8 * (i >> 2) + 4 * n + (i & 3); }

struct Unit { int pm, pn; };
struct Gemm { const bf16_t* A; const bf16_t* Bt; int M, N, K; };

struct StaticOrder {
    int nM, nN, nwg, G, c;
    __host__ __device__ void init(int M, int N, int G_, int c_) { nM = M / BM; nN = N / BM; nwg = nM * nN; G = G_; c = c_; }
    __host__ __device__ bool next(int i, Unit& u) const {
        const long L = (long)i * G + c; if (L >= nwg) return false;
        int wgid = (int)L; { const int q = nwg / NXCD, r = nwg % NXCD, xcd = wgid % NXCD, off = wgid / NXCD; wgid = (xcd < r ? xcd * (q + 1) : r * (q + 1) + (xcd - r) * q) + off; }
        const int nig = WGM * nN, gid = wgid / nig, fm = gid * WGM, gsz = (nM - fm) < WGM ? (nM - fm) : WGM;
        u.pm = fm + ((wgid % nig) % gsz); u.pn = (wgid % nig) / gsz; return true;
    }
    __device__ __forceinline__ void a_ready(const Unit&) const {}
    __device__ __forceinline__ void done(const Unit&) const {}
};

__device__ __forceinline__ unsigned cvt_pk_bf16(float lo, float hi) { unsigned r; asm volatile("v_cvt_pk_bf16_f32 %0, %1, %2" : "=v"(r) : "v"(lo), "v"(hi)); return r; }
template <class Epi, class Sched, bool ALIGN_EPI = false, bool SP2 = false>
__device__ __forceinline__ void gemm_phase(PG8_LAS unsigned char* lds, const Gemm g, const Sched& S, const Epi& E) {
    const int tid = launder_tid(), wid = __builtin_amdgcn_readfirstlane(tid >> 6), lane = tid & 63, wr = wid >> 2, wc = wid & 3, fr = lane & 15, fq = lane >> 4;
    const int K = g.K, nt = K / BK;
    unsigned voffA[2], voffB[2];
#pragma unroll
    for (int i = 0; i < 2; ++i) { int R, C; stage_rc(tid * 16 + i * 8192, R, C); const int Rb = Epi::PERM ? ((R & ~31) + perm32(R & 31)) : R;
        voffA[i] = (unsigned)(R * K + C) * 2u; voffB[i] = (unsigned)(Rb * K + C) * 2u; }
    const size_t kstep = (size_t)(BK * 2);
    const size_t hstep = (size_t)HALF * K * 2;
    const size_t tstep = 2 * hstep;
    const unsigned ldsw = (unsigned)wid * 1024u;
    const int aoff = lds_byte(wr * 64 + fr, fq * 8), boff = lds_byte(wc * 32 + fr, fq * 8);
#define PG8_SA(b, h) (((b) * 2 + (h)) * HTB)
#define PG8_SB(b, h) ((4 + (b) * 2 + (h)) * HTB)
#define PG8_STAGE(bufoff, gbase, voff) do { _Pragma("unroll") for (int _i = 0; _i < 2; ++_i) \
        __builtin_amdgcn_global_load_lds((const unsigned*)((const char*)(gbase) + (voff)[_i]), (PG8_LAS unsigned*)(lds + (bufoff) + ldsw + _i * 8192), 16, 0, 0); } while (0)
#define PG8_LDA(dst, b, h) do { _Pragma("unroll") for (int m = 0; m < 4; ++m) _Pragma("unroll") for (int k = 0; k < 2; ++k) dst[m][k] = *(const PG8_LAS bf16x8*)(lds + PG8_SA(b, h) + aoff + m * 2048 + k * 1024); } while (0)
#define PG8_LDB(dst, b, h) do { _Pragma("unroll") for (int n = 0; n < 2; ++n) _Pragma("unroll") for (int k = 0; k < 2; ++k) dst[n][k] = *(const PG8_LAS bf16x8*)(lds + PG8_SB(b, h) + boff + n * 2048 + k * 1024); } while (0)
#define PG8_MMA(ai, bj, At, Bt) do { __builtin_amdgcn_s_setprio(1); _Pragma("unroll") for (int m = 0; m < 4; ++m) _Pragma("unroll") for (int n = 0; n < 2; ++n) _Pragma("unroll") for (int k = 0; k < 2; ++k) \
        acc[ai][bj][m][n] = __builtin_amdgcn_mfma_f32_16x16x32_bf16(Bt[n][k], At[m][k], acc[ai][bj][m][n], 0, 0, 0); __builtin_amdgcn_s_setprio(0); } while (0)
#define PG8_WAIT_V(n) asm volatile("s_waitcnt vmcnt(" #n ")" ::: "memory")
#define PG8_WAIT_L(n) asm volatile("s_waitcnt lgkmcnt(" #n ")" ::: "memory")
#define PG8_BAR __builtin_amdgcn_s_barrier()
#define PG8_SCHED __builtin_amdgcn_sched_barrier(0)
    Unit cur, nxt; int ui = 0;
    if (!S.next(0, cur)) return;
    f32x4 acc[2][2][4][2];
#pragma unroll
    for (int a = 0; a < 2; ++a)
#pragma unroll
        for (int b = 0; b < 2; ++b)
#pragma unroll
            for (int m = 0; m < 4; ++m)
#pragma unroll
                for (int n = 0; n < 2; ++n) acc[a][b][m][n] = (f32x4){0.f, 0.f, 0.f, 0.f};
    bf16x8 At[4][2], B0[2][2], B1[2][2];
    const char* cA = (const char*)g.A + (size_t)cur.pm * tstep; const char* cB = (const char*)g.Bt + (size_t)cur.pn * tstep;
    S.a_ready(cur);
    if constexpr (SP2) {
        PG8_STAGE(PG8_SB(0, 0), cB, voffB); PG8_STAGE(PG8_SB(0, 1), cB + hstep, voffB); PG8_STAGE(PG8_SA(0, 0), cA, voffA); PG8_STAGE(PG8_SA(0, 1), cA + hstep, voffA);
        if (wr == 1) PG8_BAR;
        PG8_WAIT_V(2); PG8_BAR;
        PG8_STAGE(PG8_SB(1, 0), cB + kstep, voffB); PG8_STAGE(PG8_SA(1, 0), cA + kstep, voffA); PG8_STAGE(PG8_SB(1, 1), cB + hstep + kstep, voffB);
        PG8_WAIT_V(6); PG8_BAR;
    } else {
        PG8_STAGE(PG8_SB(0, 0), cB, voffB); PG8_STAGE(PG8_SA(0, 0), cA, voffA); PG8_STAGE(PG8_SB(0, 1), cB + hstep, voffB); PG8_STAGE(PG8_SA(0, 1), cA + hstep, voffA);
        if (wr == 1) PG8_BAR;
        PG8_WAIT_V(4); PG8_BAR;
        PG8_STAGE(PG8_SB(1, 0), cB + kstep, voffB); PG8_STAGE(PG8_SA(1, 0), cA + kstep, voffA); PG8_STAGE(PG8_SB(1, 1), cB + hstep + kstep, voffB);
        PG8_WAIT_V(6); PG8_BAR;
    }
    for (;;) {
        const bool has_next = S.next(ui + 1, nxt);
        const char* nA = has_next ? (const char*)g.A + (size_t)nxt.pm * tstep : cA; const char* nB = has_next ? (const char*)g.Bt + (size_t)nxt.pn * tstep : cB;
        for (int t = 0; t < nt; t += 2) {
            const bool last = (t == nt - 2);
            const char* a1 = cA + (size_t)(t + 1) * kstep;
            const char* a2 = last ? nA : cA + (size_t)(t + 2) * kstep; const char* b2 = last ? nB : cB + (size_t)(t + 2) * kstep;
            const char* a3 = a2 + kstep; const char* b3 = b2 + kstep;
            if (last && has_next) S.a_ready(nxt);
            if constexpr (SP2) {
            PG8_LDB(B0, 0, 0); PG8_LDB(B1, 0, 1); PG8_SCHED; PG8_LDA(At, 0, 0); PG8_STAGE(PG8_SA(1, 1), a1 + hstep, voffA);
            PG8_WAIT_V(8); PG8_WAIT_L(0); PG8_BAR; PG8_MMA(0, 0, At, B0); PG8_MMA(0, 1, At, B1); PG8_BAR; PG8_SCHED;
            PG8_LDA(At, 0, 1); PG8_STAGE(PG8_SB(0, 0), b2, voffB); PG8_STAGE(PG8_SB(0, 1), b2 + hstep, voffB); PG8_STAGE(PG8_SA(0, 0), a2, voffA);
            PG8_WAIT_V(8); PG8_WAIT_L(0); PG8_BAR; PG8_MMA(1, 0, At, B0); PG8_MMA(1, 1, At, B1); PG8_BAR; PG8_SCHED;
            PG8_LDB(B0, 1, 0); PG8_LDB(B1, 1, 1); PG8_SCHED; PG8_LDA(At, 1, 0); PG8_STAGE(PG8_SA(0, 1), a2 + hstep, voffA);
            PG8_WAIT_V(8); PG8_WAIT_L(0); PG8_BAR; PG8_MMA(0, 0, At, B0); PG8_MMA(0, 1, At, B1); PG8_BAR; PG8_SCHED;
            PG8_LDA(At, 1, 1); PG8_STAGE(PG8_SB(1, 0), b3, voffB); PG8_STAGE(PG8_SB(1, 1), b3 + hstep, voffB); PG8_STAGE(PG8_SA(1, 0), a3, voffA);
            PG8_WAIT_V(8); PG8_WAIT_L(0); PG8_BAR; PG8_MMA(1, 0, At, B0); PG8_MMA(1, 1, At, B1); PG8_BAR; PG8_SCHED;
            } else {
            PG8_LDB(B0, 0, 0); PG8_SCHED; PG8_LDA(At, 0, 0); PG8_STAGE(PG8_SA(1, 1), a1 + hstep, voffA);
            PG8_WAIT_L(8); PG8_BAR; PG8_WAIT_L(0); PG8_MMA(0, 0, At, B0); PG8_BAR; PG8_SCHED;
            PG8_LDB(B1, 0, 1); PG8_STAGE(PG8_SB(0, 0), b2, voffB);
            PG8_BAR; PG8_WAIT_L(0); PG8_MMA(0, 1, At, B1); PG8_BAR;
            PG8_LDA(At, 0, 1); PG8_STAGE(PG8_SA(0, 0), a2, voffA);
            PG8_BAR; PG8_WAIT_L(0); PG8_MMA(1, 0, At, B0); PG8_BAR; PG8_SCHED;
            PG8_STAGE(PG8_SB(0, 1), b2 + hstep, voffB);
            PG8_WAIT_V(6); PG8_BAR; PG8_MMA(1, 1, At, B1); PG8_BAR;
            PG8_LDB(B0, 1, 0); PG8_SCHED; PG8_LDA(At, 1, 0); PG8_STAGE(PG8_SA(0, 1), a2 + hstep, voffA);
            PG8_WAIT_L(8); PG8_BAR; PG8_WAIT_L(0); PG8_MMA(0, 0, At, B0); PG8_BAR; PG8_SCHED;
            PG8_LDB(B1, 1, 1); PG8_STAGE(PG8_SB(1, 0), b3, voffB);
            PG8_BAR; PG8_WAIT_L(0); PG8_MMA(0, 1, At, B1); PG8_BAR;
            PG8_LDA(At, 1, 1); PG8_STAGE(PG8_SA(1, 0), a3, voffA);
            PG8_BAR; PG8_WAIT_L(0); PG8_MMA(1, 0, At, B0); PG8_BAR; PG8_SCHED;
            PG8_STAGE(PG8_SB(1, 1), b3 + hstep, voffB);
            PG8_WAIT_V(6); PG8_BAR; PG8_MMA(1, 1, At, B1); PG8_BAR;
            }
        }
        if constexpr (ALIGN_EPI) { if (wr == 0) PG8_BAR; }
        if constexpr (!Epi::AFTER_DRAIN) { E(acc, cur, wr, wc, fr, fq); S.done(cur); }
        if (!has_next) break;
#pragma unroll
        for (int a = 0; a < 2; ++a)
#pragma unroll
            for (int b = 0; b < 2; ++b)
#pragma unroll
                for (int m = 0; m < 4; ++m)
#pragma unroll
                    for (int n = 0; n < 2; ++n) acc[a][b][m][n] = (f32x4){0.f, 0.f, 0.f, 0.f};
        cur = nxt; cA = nA; cB = nB; ++ui;
        if constexpr (ALIGN_EPI) { if (wr == 1) PG8_BAR; }
    }
    PG8_WAIT_V(0);
    if constexpr (!ALIGN_EPI) { if (wr == 0) PG8_BAR; }
    PG8_BAR;
    if constexpr (Epi::AFTER_DRAIN) { E.fused(acc, cur, wr, wc, fr, fq, lds, wid, lane); S.done(cur); }
#undef PG8_SA
#undef PG8_SB
#undef PG8_STAGE
#undef PG8_LDA
#undef PG8_LDB
#undef PG8_MMA
#undef PG8_WAIT_V
#undef PG8_WAIT_L
#undef PG8_BAR
#undef PG8_SCHED
}
}

struct EpiBf16 {
    static constexpr bool PERM = true, AFTER_DRAIN = false;
    bf16_t* O; int ldc;
    __device__ __forceinline__ void operator()(const f32x4 (&acc)[2][2][4][2], const pg8::Unit& u, int wr, int wc, int fr, int fq) const {
        const int row0 = u.pm * 256 + wr * 64 + fr, col0 = u.pn * 256 + wc * 32 + 8 * fq;
#pragma unroll
        for (int ai = 0; ai < 2; ++ai)
#pragma unroll
            for (int m = 0; m < 4; ++m) { bf16_t* rowp = O + (size_t)(row0 + ai * 128 + m * 16) * ldc + col0;
#pragma unroll
                for (int bj = 0; bj < 2; ++bj) { const f32x4 v0 = acc[ai][bj][m][0], v1 = acc[ai][bj][m][1];
                    u32x4 w; w.x = pk2(v0[0], v0[1]); w.y = pk2(v0[2], v0[3]); w.z = pk2(v1[0], v1[1]); w.w = pk2(v1[2], v1[3]);
                    *(u32x4*)(rowp + bj * 128) = w; } }
    }
};
struct EpiResid {
    static constexpr bool PERM = true, AFTER_DRAIN = false;
    const float* in; float* out; bool real;
    __device__ __forceinline__ void operator()(const f32x4 (&acc)[2][2][4][2], const pg8::Unit& u, int wr, int wc, int fr, int fq) const {
        const int row0 = u.pm * 256 + wr * 64 + fr, col0 = u.pn * 256 + wc * 32 + 8 * fq;
#pragma unroll
        for (int ai = 0; ai < 2; ++ai)
#pragma unroll
            for (int m = 0; m < 4; ++m) { const size_t ro = (size_t)(row0 + ai * 128 + m * 16) * DM + col0;
#pragma unroll
                for (int bj = 0; bj < 2; ++bj)
#pragma unroll
                    for (int n = 0; n < 2; ++n) { const size_t o = ro + bj * 128 + 4 * n; f32x4 v = *(const f32x4*)(in + o); v += acc[ai][bj][m][n]; if (real || v[0] == 1.2345e30f) *(f32x4*)(out + o) = v; } }
    }
};
struct EpiSwiglu {
    static constexpr bool PERM = true, AFTER_DRAIN = false;
    bf16_t* O;
    __device__ __forceinline__ void operator()(const f32x4 (&acc)[2][2][4][2], const pg8::Unit& u, int wr, int wc, int fr, int fq) const {
        const int row0 = u.pm * 256 + wr * 64 + fr, col0 = u.pn * 128 + wc * 32 + 8 * fq;
#pragma unroll
        for (int ai = 0; ai < 2; ++ai)
#pragma unroll
            for (int m = 0; m < 4; ++m) { bf16_t* rowp = O + (size_t)(row0 + ai * 128 + m * 16) * FF_ + col0;
                float r[8];
#pragma unroll
                for (int n = 0; n < 2; ++n)
#pragma unroll
                    for (int j = 0; j < 4; ++j) r[4 * n + j] = siluf_(acc[ai][0][m][n][j]) * acc[ai][1][m][n][j];
                u32x4 w; w.x = pk2(r[0], r[1]); w.y = pk2(r[2], r[3]); w.z = pk2(r[4], r[5]); w.w = pk2(r[6], r[7]);
                *(u32x4*)rowp = w; }
    }
};
struct EpiOddIn {
    static constexpr bool PERM = true, AFTER_DRAIN = false;
    unsigned char* big;
    __device__ __forceinline__ void operator()(const f32x4 (&acc)[2][2][4][2], const pg8::Unit& u, int wr, int wc, int fr, int fq) const {
        const int row0 = u.pm * 256 + wr * 64 + fr, pn = u.pn, ci = wc * 32 + 8 * fq;
        if (pn < 8) {
            const int head = pn & 3; const bool isk = pn >= 4;
            const float lg = __log2f(1.0f - exp2f(-5.0f - (float)head));
            bf16_t* rm = (bf16_t*)(big + (isk ? OB_KT : OB_QT));
            bf16_t* tr = (bf16_t*)(big + OB_KTT);
#pragma unroll
            for (int ai = 0; ai < 2; ++ai)
#pragma unroll
                for (int m = 0; m < 4; ++m) { const int t = row0 + ai * 128 + m * 16; const float jp = (float)((t & 255) + 1);
                    const float dec = isk ? __builtin_amdgcn_exp2f(-jp * lg) * 0.0625f : __builtin_amdgcn_exp2f(jp * lg);
                    bf16_t* rp = rm + (size_t)head * 256 * S_ + rb_off(8, t, ci);
                    bf16_t* tp = tr + (size_t)head * 256 * S_ + tb_off(256, ci, t);
#pragma unroll
                    for (int n = 0; n < 2; ++n) {
                        float y1[4], y2[4];
#pragma unroll
                        for (int j = 0; j < 4; ++j) { const float ang = (float)t * __builtin_amdgcn_exp2f(-(float)(ci + 4 * n + j) * 0.10381025296523008f);
                            const float kk = __builtin_rintf(ang * 0.15915494309189535f);
                            float rr = __builtin_fmaf(-kk, 6.28125f, ang); rr = __builtin_fmaf(-kk, 0.0019353071795864769f, rr); const float fr_ = rr * 0.15915494309189535f;
                            const float sn = __builtin_amdgcn_sinf(fr_), cs = __builtin_amdgcn_cosf(fr_);
                            const float x1 = acc[ai][0][m][n][j], x2 = acc[ai][1][m][n][j];
                            y1[j] = (x1 * cs - x2 * sn) * dec; y2[j] = (x1 * sn + x2 * cs) * dec; }
                        u32x2 w; w.x = pk2(y1[0], y1[1]); w.y = pk2(y1[2], y1[3]); *(u32x2*)(rp + 4 * n) = w;
                        w.x = pk2(y2[0], y2[1]); w.y = pk2(y2[2], y2[3]); *(u32x2*)(rp + 4 * 512 + 4 * n) = w;
                        if (isk) {
#pragma unroll
                            for (int j = 0; j < 4; ++j) { tp[(4 * n + j) * 32] = (bf16_t)f2bf(y1[j]); tp[(128 + 4 * n + j) * 32] = (bf16_t)f2bf(y2[j]); }
                        }
                        __builtin_amdgcn_sched_barrier(0);
                    } }
        } else if (pn < 16) {
            const int vh = (pn - 8) >> 1, dv0 = ((pn - 8) & 1) * 256 + ci;
            bf16_t* tr = (bf16_t*)(big + OB_VTT) + (size_t)vh * 512 * S_;
#pragma unroll
            for (int ai = 0; ai < 2; ++ai)
#pragma unroll
                for (int m = 0; m < 4; ++m) { const int t = row0 + ai * 128 + m * 16; bf16_t* tp = tr + tb_off(512, dv0, t);
#pragma unroll
                    for (int bj = 0; bj < 2; ++bj)
#pragma unroll
                        for (int e = 0; e < 8; ++e) tp[(bj * 128 + e) * 32] = (bf16_t)f2bf(acc[ai][bj][m][e >> 2][e & 3]); }
        } else {
            bf16_t* d0; bf16_t* d1; int ld; bool t1 = false; bool v0ok = true, v1ok = true;
            if (pn < 24)      { d0 = (bf16_t*)(big + OB_GC) + (pn - 16) * 256 + ci; d1 = d0 + 128; ld = 2048; }
            else if (pn < 28) { d0 = (bf16_t*)(big + OB_QD) + (pn - 24) * 256 + ci; d1 = d0 + 128; ld = 1024; }
            else if (pn == 28) { d0 = (bf16_t*)(big + OB_KCMP) + ci; d1 = (bf16_t*)(big + OB_VCMP) + ci; ld = 128; }
            else if (pn == 29) { d0 = (bf16_t*)(big + OB_KSLC); d1 = (bf16_t*)(big + OB_VSLCT); ld = 0; t1 = true; }
            else if (pn == 30) { d0 = (bf16_t*)(big + OB_KWIN); d1 = (bf16_t*)(big + OB_VWIN); ld = 0; t1 = true; }
            else               { d0 = (bf16_t*)(big + OB_GD) + ci; d1 = d0; ld = 64; v0ok = ci < 64; v1ok = false; }
#pragma unroll
            for (int ai = 0; ai < 2; ++ai)
#pragma unroll
                for (int m = 0; m < 4; ++m) { const int t = row0 + ai * 128 + m * 16;
                    if (v0ok) { const f32x4 v0 = acc[ai][0][m][0], v1 = acc[ai][0][m][1];
                        u32x4 w; w.x = pk2(v0[0], v0[1]); w.y = pk2(v0[2], v0[3]); w.z = pk2(v1[0], v1[1]); w.w = pk2(v1[2], v1[3]);
                        *(u32x4*)(t1 ? d0 + (size_t)(ci >> 6) * 64 * S_ + rb_off(2, t, ci & 63) : d0 + (size_t)t * ld) = w; }
                    if (v1ok) {
                        if (t1) {
#pragma unroll
                            for (int e = 0; e < 8; ++e) d1[(size_t)(ci >> 6) * 64 * S_ + tb_off(64, (ci & 63) + e, t)] = (bf16_t)f2bf(acc[ai][1][m][e >> 2][e & 3]);
                        } else { const f32x4 v0 = acc[ai][1][m][0], v1 = acc[ai][1][m][1];
                            u32x4 w; w.x = pk2(v0[0], v0[1]); w.y = pk2(v0[2], v0[3]); w.z = pk2(v1[0], v1[1]); w.w = pk2(v1[2], v1[3]); *(u32x4*)(d1 + (size_t)t * ld) = w; } } }
        }
    }
};

__device__ __forceinline__ void conv_tile(const float* src, int ld, int K, int col0, int ncv, bf16_t* dstrow0, int k0, LAS float* tile, int tid) {
#pragma unroll
    for (int i = 0; i < 8; ++i) { const int kk = (tid >> 6) + 8 * i, nn = tid & 63;
        tile[kk * 65 + nn] = nn < ncv ? src[(size_t)(k0 + kk) * ld + col0 + nn] : 0.f; }
    __syncthreads();
    { const int nn = tid >> 3, kc = (tid & 7) * 8; float v[8];
#pragma unroll
      for (int j = 0; j < 8; ++j) v[j] = tile[(kc + j) * 65 + nn];
      u32x4 w; w.x = pk2(v[0], v[1]); w.y = pk2(v[2], v[3]); w.z = pk2(v[4], v[5]); w.w = pk2(v[6], v[7]);
      *(u32x4*)(dstrow0 + (size_t)nn * K + k0 + kc) = w; }
    __syncthreads();
}

__device__ __forceinline__ void phase_convert(const Params& p, int layer, LAS unsigned char* lds) {
    const int tid = launder_tid(); LAS float* tile = (LAS float*)lds;
    const int li = layer >> 1; const bool odd = layer & 1;
    unsigned char* ws = launder_ptr(p.ws);
    const int n_in = odd ? 128 * 16 : 36 * 16, n_out = odd ? 16 * 48 : 16 * 16, n_gu = 88 * 16, n_dn = 16 * 44, n_c1 = odd ? 2 * 32 : 0, n_c2 = odd ? 2 : 0, n_bv = odd ? 2 : 0;
    const int o_out = n_in, o_gu = o_out + n_out, o_dn = o_gu + n_gu, o_c1k = o_dn + n_dn, o_c1v = o_c1k + n_c1, o_c2k = o_c1v + n_c1, o_c2v = o_c2k + n_c2, o_bv = o_c2v + n_c2, total = o_bv + n_bv;
    for (int u = blockIdx.x; u < total; u += gridDim.x) {
        if (u < o_out) { const int nt = u >> 4, kt = u & 15;
            if (odd) { const int Ns = 7984; const float* src = p.odd_w_in + (size_t)li * 1024 * Ns; int ncv = Ns - nt * 64; ncv = ncv > 64 ? 64 : (ncv < 0 ? 0 : ncv);
                conv_tile(src, Ns, 1024, nt * 64, ncv, (bf16_t*)(ws + WS_WIN) + (size_t)nt * 64 * 1024, kt * 64, tile, tid); }
            else { const float* src = p.even_w_in + (size_t)li * 1024 * 2304; conv_tile(src, 2304, 1024, nt * 64, 64, (bf16_t*)(ws + WS_WIN) + (size_t)nt * 64 * 1024, kt * 64, tile, tid); }
        } else if (u < o_gu) { const int v = u - o_out; const int KO = odd ? 3072 : 1024, nk = KO / 64; const int nt = v / nk, kt = v % nk;
            const float* src = odd ? p.odd_w_out + (size_t)li * 3072 * 1024 : p.even_w_out + (size_t)li * 1024 * 1024;
            conv_tile(src, 1024, KO, nt * 64, 64, (bf16_t*)(ws + WS_WOUT) + (size_t)nt * 64 * KO, kt * 64, tile, tid);
        } else if (u < o_dn) { const int v = u - o_gu; const int q = v >> 4, kt = v & 15; const int pn = q >> 2, bj = (q >> 1) & 1, i0 = 64 * (q & 1);
            const float* src = (bj ? p.ffn_w_up : p.ffn_w_gate) + (size_t)layer * 1024 * FF_;
            conv_tile(src, FF_, 1024, 128 * pn + i0, 64, (bf16_t*)(ws + WS_WGU) + (size_t)q * 64 * 1024, kt * 64, tile, tid);
        } else if (u < o_c1k) { const int v = u - o_dn; const int nt = v / 44, kt = v % 44;
            const float* src = p.ffn_w_down + (size_t)layer * FF_ * 1024;
            conv_tile(src, 1024, FF_, nt * 64, 64, (bf16_t*)(ws + WS_WDN) + (size_t)nt * 64 * FF_, kt * 64, tile, tid);
        } else if (u < o_c2k) { const bool isv = u >= o_c1v; const int v = u - (isv ? o_c1v : o_c1k); const int nt = v >> 5, kt = v & 31;
            const float* src = (isv ? p.odd_cmp_v_w1 : p.odd_cmp_k_w1) + (size_t)li * 2048 * 128;
            conv_tile(src, 128, 2048, nt * 64, 64, (bf16_t*)(ws + WS_WC1 + (isv ? 512 * 1024 : 0)) + (size_t)nt * 64 * 2048, kt * 64, tile, tid);
        } else if (u < o_bv) { const bool isv = u >= o_c2v; const int kt = u - (isv ? o_c2v : o_c2k);
            const float* src = (isv ? p.odd_cmp_v_w2 : p.odd_cmp_k_w2) + (size_t)li * 128 * 64;
            conv_tile(src, 64, 128, 0, 64, (bf16_t*)(ws + WS_WC2 + (isv ? 16384 : 0)), kt * 64, tile, tid);
        } else { const bool isv = (u - o_bv) == 1;
            const float* pos = (isv ? p.odd_cmp_pos_v : p.odd_cmp_pos_k) + (size_t)li * 2048; const float* w1 = (isv ? p.odd_cmp_v_w1 : p.odd_cmp_k_w1) + (size_t)li * 2048 * 128;
            const int hid = tid & 127, part = tid >> 7; float s = 0.f;
            for (int k = part * 512; k < part * 512 + 512; ++k) s += pos[k] * w1[(size_t)k * 128 + hid];
            tile[part * 128 + hid] = s; __syncthreads();
            if (tid < 128) ((float*)(ws + WS_SMALL))[(isv ? 128 : 0) + tid] = tile[tid] + tile[128 + tid] + tile[256 + tid] + tile[384 + tid];
            __syncthreads();
        }
    }
}

__device__ __forceinline__ void phase_rmsnorm(const float* src, const float* w, bf16_t* dstb, float* dstf, int row0 = 0, int row1 = M_) {
    const int tid_ = launder_tid(); const int lane = tid_ & 63, wave = tid_ >> 6;
    f32x4 wv[4];
#pragma unroll
    for (int i = 0; i < 4; ++i) wv[i] = *(const f32x4*)(w + 256 * i + 4 * lane);
    for (int row = row0 + blockIdx.x * 8 + wave; row < row1; row += gridDim.x * 8) {
        const float* rp = src + (size_t)row * DM; f32x4 v[4]; float ss = 0.f;
#pragma unroll
        for (int i = 0; i < 4; ++i) { v[i] = *(const f32x4*)(rp + 256 * i + 4 * lane); ss += v[i][0] * v[i][0] + v[i][1] * v[i][1] + v[i][2] * v[i][2] + v[i][3] * v[i][3]; }
#pragma unroll
        for (int o = 32; o >= 1; o >>= 1) ss += shx(ss, o, lane);
        const float rs = rsqrtf(ss * (1.0f / 1024.0f) + 1e-6f);
#pragma unroll
        for (int i = 0; i < 4; ++i) { const f32x4 y = v[i] * rs * wv[i];
            if (dstb) { u32x2 o2; o2.x = pk2(y[0], y[1]); o2.y = pk2(y[2], y[3]); *(u32x2*)(dstb + (size_t)row * DM + 256 * i + 4 * lane) = o2; }
            else *(f32x4*)(dstf + (size_t)row * DM + 256 * i + 4 * lane) = y; }
    }
}


template <bool VT>
__device__ __forceinline__ void band_unit(const bf16_t* Q, int ldq, const bf16_t* K, int ldk, const bf16_t* V, int ldv,
                                          int L, int dil, int res, int maxd, int head, int i0,
                                          bf16_t* O, int ldo, float* lse, int ldl, const bf16_t* gate, int ldg,
                                          bool has_sink, float sink, const LAS float* tbl, int lane) {
    const int g = lane >> 4, c = lane & 15;
    const int iq = i0 + c; const int tq = res + dil * iq;
    const bf16_t* qp = Q + (size_t)tq * ldq + 8 * g;
    const bf16x8 qf0 = *(const bf16x8*)qp, qf1 = *(const bf16x8*)(qp + 32);
    float m = has_sink ? sink : -1e30f, l = (has_sink && g == 0) ? 1.0f : 0.0f;
    f32x4 acc[4];
#pragma unroll
    for (int d = 0; d < 4; ++d) acc[d] = (f32x4){0.f, 0.f, 0.f, 0.f};
    int lo = i0 - maxd; lo = lo < 0 ? 0 : lo;
    const int tlo = (lo >> 4) & ~1, thi = i0 >> 4;
    bf16x8 ck[4];
    { const int tbv0 = tlo + 1 > thi ? tlo : tlo + 1;
      const bf16_t* kpa = K + (size_t)(res + dil * (16 * tlo + c)) * ldk + 8 * g; const bf16_t* kpb = K + (size_t)(res + dil * (16 * tbv0 + c)) * ldk + 8 * g;
      ck[0] = *(const bf16x8*)kpa; ck[1] = *(const bf16x8*)(kpa + 32); ck[2] = *(const bf16x8*)kpb; ck[3] = *(const bf16x8*)(kpb + 32); }
    for (int ta = tlo; ta <= thi; ta += 2) {
        const int tb = ta + 1, tbv = tb > thi ? ta : tb;
        bf16x8 nk[4];
        { const int tna = ta + 2 <= thi ? ta + 2 : ta, tnb = tna + 1 > thi ? tna : tna + 1;
          const bf16_t* kpa = K + (size_t)(res + dil * (16 * tna + c)) * ldk + 8 * g; const bf16_t* kpb = K + (size_t)(res + dil * (16 * tnb + c)) * ldk + 8 * g;
          nk[0] = *(const bf16x8*)kpa; nk[1] = *(const bf16x8*)(kpa + 32); nk[2] = *(const bf16x8*)kpb; nk[3] = *(const bf16x8*)(kpb + 32); }
        bf16x8 vfr[4];
#pragma unroll
        for (int d = 0; d < 4; ++d) {
            if (VT) { const bf16_t* vp = V + (size_t)(16 * d + c) * ldv + 4 * g; vfr[d] = mk8(*(const u32x2*)(vp + 16 * ta), *(const u32x2*)(vp + 16 * tbv)); }
            else {
#pragma unroll
                for (int j = 0; j < 4; ++j) { vfr[d][j] = (short)V[(size_t)(res + dil * (16 * ta + 4 * g + j)) * ldv + 16 * d + c]; vfr[d][4 + j] = (short)V[(size_t)(res + dil * (16 * tbv + 4 * g + j)) * ldv + 16 * d + c]; }
            }
        }
        __builtin_amdgcn_sched_barrier(0);
        f32x4 sa = mfma16(ck[0], qf0, (f32x4){0.f, 0.f, 0.f, 0.f}); sa = mfma16(ck[1], qf1, sa);
        f32x4 sb = mfma16(ck[2], qf0, (f32x4){0.f, 0.f, 0.f, 0.f}); sb = mfma16(ck[3], qf1, sb);
        float s[8]; bool ok[8];
#pragma unroll
        for (int r = 0; r < 4; ++r) {
            const int da = iq - (16 * ta + 4 * g + r), db = iq - (16 * tb + 4 * g + r);
            ok[r] = da >= 0 && da <= maxd; ok[4 + r] = db >= 0 && db <= maxd;
            s[r] = ok[r] ? sa[r] * 0.125f + tbl[t5b(da * dil) * 16 + head] : -1e30f;
            s[4 + r] = ok[4 + r] ? sb[r] * 0.125f + tbl[t5b((db < 0 ? 0 : db) * dil) * 16 + head] : -1e30f;
        }
        float mx = fmaxf(fmaxf(fmaxf(s[0], s[1]), fmaxf(s[2], s[3])), fmaxf(fmaxf(s[4], s[5]), fmaxf(s[6], s[7])));
        mx = fmaxf(mx, shx(mx, 16, lane)); mx = fmaxf(mx, shx(mx, 32, lane));
        if (__builtin_amdgcn_ballot_w64(mx > m) != 0ull) {
            const float mn = fmaxf(m, mx), alpha = __expf(m - mn); m = mn; l *= alpha;
#pragma unroll
            for (int d = 0; d < 4; ++d) acc[d] *= alpha; }
        float pr[8], ps = 0.f;
#pragma unroll
        for (int r = 0; r < 8; ++r) { pr[r] = ok[r] ? __expf(s[r] - m) : 0.f; ps += pr[r]; }
        l += ps;
        const bf16x8 pf = mk8p(pr[0], pr[1], pr[2], pr[3], pr[4], pr[5], pr[6], pr[7]);
#pragma unroll
        for (int d = 0; d < 4; ++d) {
            acc[d] = mfma16(vfr[d], pf, acc[d]);
        }
#pragma unroll
        for (int i = 0; i < 4; ++i) ck[i] = nk[i];
    }
    l += shx(l, 16, lane); l += shx(l, 32, lane);
    float inv = 1.0f / l;
    if (lse && g == 0) lse[(size_t)tq * ldl] = m + __logf(l);
    if (gate) inv *= sigmoidf_(bf2f(gate[(size_t)tq * ldg]));
#pragma unroll
    for (int d = 0; d < 4; ++d) { u32x2 w; w.x = pk2(acc[d][0] * inv, acc[d][1] * inv); w.y = pk2(acc[d][2] * inv, acc[d][3] * inv);
        *(u32x2*)(O + (size_t)tq * ldo + 16 * d + 4 * g) = w; }
}

__device__ __forceinline__ void win_unit(const unsigned char* big, bf16_t* ob, int h, int i0, const LAS float* tbl, int lane) {
    const int g = lane >> 4, c = lane & 15, grp = h >> 3, t = i0 + c;
    const bf16_t* qp = (const bf16_t*)(big + OB_QD) + (size_t)t * 1024 + h * 64 + 8 * g;
    const bf16x8 qf0 = *(const bf16x8*)qp, qf1 = *(const bf16x8*)(qp + 32);
    const bf16_t* Kb = (const bf16_t*)(big + OB_KWIN) + (size_t)grp * 64 * S_ + c * 32 + 8 * g;
    const bf16_t* Vb = (const bf16_t*)(big + OB_VWIN) + (size_t)grp * 64 * S_ + c * 32 + 8 * g;
    float m = -1e30f, l = 0.f;
    f32x4 acc[4];
#pragma unroll
    for (int d = 0; d < 4; ++d) acc[d] = (f32x4){0.f, 0.f, 0.f, 0.f};
    int lo = i0 - 511; lo = lo < 0 ? 0 : lo;
    const int tlo = (lo >> 4) & ~1, thi = i0 >> 4;
    bf16x8 ka[4], kb[4];
    auto loadk = [&](bf16x8 (&K_)[4], int tt) __attribute__((always_inline)) { const bf16_t* kp = Kb + (size_t)tt * 1024;
        K_[0] = *(const bf16x8*)kp; K_[1] = *(const bf16x8*)(kp + 512); K_[2] = *(const bf16x8*)(kp + 1024); K_[3] = *(const bf16x8*)(kp + 1536); };
    auto step = [&](const bf16x8 (&ck)[4], int ta) __attribute__((always_inline)) {
        bf16x8 cv[4];
        { const bf16_t* vp = Vb + (size_t)ta * 1024;
#pragma unroll
          for (int d = 0; d < 4; ++d) cv[d] = *(const bf16x8*)(vp + 512 * d); }
        __builtin_amdgcn_sched_barrier(0);
        f32x4 sa = mfma16(ck[0], qf0, (f32x4){0.f, 0.f, 0.f, 0.f}); sa = mfma16(ck[1], qf1, sa);
        f32x4 sb = mfma16(ck[2], qf0, (f32x4){0.f, 0.f, 0.f, 0.f}); sb = mfma16(ck[3], qf1, sb);
        float s[8]; bool ok[8];
#pragma unroll
        for (int r = 0; r < 4; ++r) {
            const int da = t - (16 * ta + 4 * g + r), db = da - 16;
            ok[r] = da >= 0 && da <= 511; ok[4 + r] = db >= 0 && db <= 511;
            s[r] = ok[r] ? sa[r] * 0.125f + tbl[t5b(da < 0 ? 0 : da) * 16 + h] : -1e30f;
            s[4 + r] = ok[4 + r] ? sb[r] * 0.125f + tbl[t5b(db < 0 ? 0 : db) * 16 + h] : -1e30f;
        }
        float mx = fmaxf(fmaxf(fmaxf(s[0], s[1]), fmaxf(s[2], s[3])), fmaxf(fmaxf(s[4], s[5]), fmaxf(s[6], s[7])));
        mx = fmaxf(mx, shx(mx, 16, lane)); mx = fmaxf(mx, shx(mx, 32, lane));
        if (__builtin_amdgcn_ballot_w64(mx > m) != 0ull) {
            const float mn = fmaxf(m, mx), alpha = __expf(m - mn); m = mn; l *= alpha;
#pragma unroll
            for (int d = 0; d < 4; ++d) acc[d] *= alpha; }
        float pr[8], ps = 0.f;
#pragma unroll
        for (int r = 0; r < 8; ++r) { pr[r] = ok[r] ? __expf(s[r] - m) : 0.f; ps += pr[r]; }
        l += ps;
        const bf16x8 pf = mk8p(pr[0], pr[1], pr[2], pr[3], pr[4], pr[5], pr[6], pr[7]);
#pragma unroll
        for (int d = 0; d < 4; ++d) acc[d] = mfma16(cv[d], pf, acc[d]);
    };
    loadk(ka, tlo);
    for (int ta = tlo; ta <= thi; ta += 4) {
        loadk(kb, ta + 2 <= thi ? ta + 2 : ta);
        step(ka, ta);
        if (ta + 2 <= thi) { loadk(ka, ta + 4 <= thi ? ta + 4 : ta + 2); step(kb, ta + 2); }
    }
    l += shx(l, 16, lane); l += shx(l, 32, lane);
    const float inv = sigmoidf_(bf2f(((const bf16_t*)(big + OB_GD))[(size_t)t * 64 + h * 3 + 2])) / l;
#pragma unroll
    for (int d = 0; d < 4; ++d) { u32x2 w; w.x = pk2(acc[d][0] * inv, acc[d][1] * inv); w.y = pk2(acc[d][2] * inv, acc[d][3] * inv);
        *(u32x2*)(ob + (size_t)t * 3072 + 2048 + h * 64 + 16 * d + 4 * g) = w; }
}

#define SEL_LOADK(K_, k0_) do { const bf16_t* kp_ = Kb + (size_t)(k0_) * 64; _Pragma("unroll") for (int i_ = 0; i_ < 8; ++i_) K_[i_] = *(const bf16x8*)(kp_ + 512 * i_); } while (0)
#define SEL_STEP(K_, k0_) do { \
    bf16x8 cv[8]; { const bf16_t* vp_ = Vb + (size_t)(k0_) * 64; _Pragma("unroll") for (int i_ = 0; i_ < 8; ++i_) cv[i_] = *(const bf16x8*)(vp_ + 512 * i_); } \
    __builtin_amdgcn_sched_barrier(0); \
    f32x4 sc[4]; \
    _Pragma("unroll") for (int i = 0; i < 4; ++i) { sc[i] = mfma16(K_[2 * i], qf0, (f32x4){0.f, 0.f, 0.f, 0.f}); sc[i] = mfma16(K_[2 * i + 1], qf1, sc[i]); } \
    float s[16]; bool ok[16]; \
    const int dmin = t - (k0_) - 63; const int bk0 = __builtin_amdgcn_readfirstlane(t5b(dmin < 0 ? 0 : dmin)); \
    if (dmin >= 0 && bk0 == __builtin_amdgcn_readfirstlane(t5b(dmin + 63))) { const float bias = tbl[bk0 * 16 + head]; \
        _Pragma("unroll") for (int i = 0; i < 4; ++i) _Pragma("unroll") for (int r = 0; r < 4; ++r) { ok[4 * i + r] = true; s[4 * i + r] = sc[i][r] * 0.125f + bias; } \
    } else { \
        _Pragma("unroll") for (int i = 0; i < 4; ++i) _Pragma("unroll") for (int r = 0; r < 4; ++r) { const int dd = t - ((k0_) + 16 * i + 4 * g + r); ok[4 * i + r] = dd >= 0; \
            s[4 * i + r] = dd >= 0 ? sc[i][r] * 0.125f + tbl[t5b(dd) * 16 + head] : -1e30f; } \
    } \
    float mx = s[0]; \
    _Pragma("unroll") for (int r = 1; r < 16; ++r) mx = fmaxf(mx, s[r]); \
    mx = fmaxf(mx, shx(mx, 16, lane)); mx = fmaxf(mx, shx(mx, 32, lane)); \
    if (__builtin_amdgcn_ballot_w64(mx > m) != 0ull) { const float mn = fmaxf(m, mx), alpha = __expf(m - mn); m = mn; l *= alpha; \
        _Pragma("unroll") for (int d = 0; d < 4; ++d) acc[d] *= alpha; } \
    float pr[16], ps = 0.f; \
    _Pragma("unroll") for (int r = 0; r < 16; ++r) { pr[r] = ok[r] ? __expf(s[r] - m) : 0.f; ps += pr[r]; } \
    l += ps; \
    const bf16x8 pf0 = mk8p(pr[0], pr[1], pr[2], pr[3], pr[4], pr[5], pr[6], pr[7]), pf1 = mk8p(pr[8], pr[9], pr[10], pr[11], pr[12], pr[13], pr[14], pr[15]); \
    _Pragma("unroll") for (int d = 0; d < 4; ++d) { acc[d] = mfma16(cv[d], pf0, acc[d]); acc[d] = mfma16(cv[4 + d], pf1, acc[d]); } } while (0)
__device__ __forceinline__ void sel_unit(const unsigned char* big, const int* idx, bf16_t* ob, int t, int grp, const LAS float* tbl, int lane, bool real = true) {
    const int g = lane >> 4, c = lane & 15, head = grp * 8 + (c & 7);
    const bf16_t* qp = (const bf16_t*)(big + OB_QD) + (size_t)t * 1024 + head * 64 + 8 * g;
    const bf16x8 qf0 = *(const bf16x8*)qp, qf1 = *(const bf16x8*)(qp + 32);
    const bf16_t* Kb = (const bf16_t*)(big + OB_KSLC) + (size_t)grp * 64 * S_ + c * 32 + 8 * g;
    const bf16_t* Vb = (const bf16_t*)(big + OB_VSLCT) + (size_t)grp * 64 * S_ + c * 32 + 8 * g;
    float m = -1e30f, l = 0.f;
    f32x4 acc[4];
#pragma unroll
    for (int d = 0; d < 4; ++d) acc[d] = (f32x4){0.f, 0.f, 0.f, 0.f};
    const int* ip = idx + ((size_t)t * 2 + grp) * 16;
    int nsel = (t >> 6) + 1; nsel = nsel > 16 ? 16 : nsel;
    int k0a = __builtin_amdgcn_readfirstlane(ip[0]) * 64;
    bf16x8 ka[8], kb[8];
    SEL_LOADK(ka, k0a);
    for (int si = 0; si < nsel; si += 2) {
        const int s1 = si + 1 < nsel ? si + 1 : si;
        const int k0b = __builtin_amdgcn_readfirstlane(ip[s1]) * 64;
        SEL_LOADK(kb, k0b);
        SEL_STEP(ka, k0a);
        if (si + 1 < nsel) {
            const int s2 = si + 2 < nsel ? si + 2 : s1;
            const int k0n = __builtin_amdgcn_readfirstlane(ip[s2]) * 64;
            SEL_LOADK(ka, k0n);
            SEL_STEP(kb, k0b);
            k0a = k0n;
        }
    }
    l += shx(l, 16, lane); l += shx(l, 32, lane);
    if (c < 8 && real) {
        const float gt = sigmoidf_(bf2f(((const bf16_t*)(big + OB_GD))[(size_t)t * 64 + head * 3 + 1])) / l;
#pragma unroll
        for (int d = 0; d < 4; ++d) { bf16_t* op = ob + (size_t)t * 3072 + 2048 + head * 64 + 16 * d + 4 * g; const u32x2 o = *(const u32x2*)op;
            u32x2 w; w.x = pk2(bflo(o.x) + acc[d][0] * gt, bfhi(o.x) + acc[d][1] * gt); w.y = pk2(bflo(o.y) + acc[d][2] * gt, bfhi(o.y) + acc[d][3] * gt); *(u32x2*)op = w; }
    }
}

__device__ __forceinline__ void cmp_unit(const unsigned char* big, const unsigned char* misc, int* idx, bf16_t* ob, int t0, int grp, const LAS float* tbl, LAS float* impall, int wave, int lane, bool real = true) {
    const int g = lane >> 4, c = lane & 15, t = t0 + c, head = grp * 8 + wave;
    LAS float* imp = impall + wave * (16 * 257);
    for (int i = lane; i < 16 * 257; i += 64) imp[i] = 0.f;
    asm volatile("" ::: "memory");
    int cnt = t0 >> 4; cnt = cnt > 1023 ? 1023 : cnt;
    const int npair = (cnt + 31) >> 5;
    const bf16_t* KC = (const bf16_t*)(misc + MS_KC) + (size_t)grp * 65536 + c * 32 + 8 * g;
    const bf16_t* VCT = (const bf16_t*)(misc + MS_VCT) + (size_t)grp * 65536 + c * 32 + 8 * g;
    if (cnt > 0) {
        const bf16_t* qp = (const bf16_t*)(big + OB_QD) + (size_t)t * 1024 + head * 64 + 8 * g;
        const bf16x8 qf0 = *(const bf16x8*)qp, qf1 = *(const bf16x8*)(qp + 32);
        float m = -1e30f, l = 0.f;
        bf16x8 ck[4];
        ck[0] = *(const bf16x8*)KC; ck[1] = *(const bf16x8*)(KC + 512); ck[2] = *(const bf16x8*)(KC + 1024); ck[3] = *(const bf16x8*)(KC + 1536);
        for (int pi = 0; pi < npair; ++pi) {
            const int pn = pi + 1 < npair ? pi + 1 : pi; const bf16_t* kp = KC + (size_t)pn * 2048;
            bf16x8 nk[4]; nk[0] = *(const bf16x8*)kp; nk[1] = *(const bf16x8*)(kp + 512); nk[2] = *(const bf16x8*)(kp + 1024); nk[3] = *(const bf16x8*)(kp + 1536);
            __builtin_amdgcn_sched_barrier(0);
            f32x4 sa = mfma16(ck[0], qf0, (f32x4){0.f, 0.f, 0.f, 0.f}); sa = mfma16(ck[1], qf1, sa);
            f32x4 sb = mfma16(ck[2], qf0, (f32x4){0.f, 0.f, 0.f, 0.f}); sb = mfma16(ck[3], qf1, sb);
            float s[8]; bool ok[8];
            const int dmin = t0 - (16 * (32 * pi + 31) + 31); const int bk0 = __builtin_amdgcn_readfirstlane(t5b(dmin < 0 ? 0 : dmin));
            if (dmin >= 0 && pi < 31 && bk0 == __builtin_amdgcn_readfirstlane(t5b(dmin + 511))) {
                const float bias = tbl[bk0 * 16 + head];
#pragma unroll
                for (int r = 0; r < 4; ++r) { ok[r] = true; ok[4 + r] = true; s[r] = sa[r] * 0.125f + bias; s[4 + r] = sb[r] * 0.125f + bias; }
            } else {
#pragma unroll
                for (int r = 0; r < 4; ++r) {
                    const int na = 32 * pi + 4 * g + r, nb = na + 16; const int da = t - (16 * na + 31), db = da - 256;
                    ok[r] = da >= 0 && na < 1023; ok[4 + r] = db >= 0 && nb < 1023;
                    s[r] = ok[r] ? sa[r] * 0.125f + tbl[t5b(da) * 16 + head] : -1e30f;
                    s[4 + r] = ok[4 + r] ? sb[r] * 0.125f + tbl[t5b(db < 0 ? 0 : db) * 16 + head] : -1e30f;
                }
            }
            float mx = fmaxf(fmaxf(fmaxf(s[0], s[1]), fmaxf(s[2], s[3])), fmaxf(fmaxf(s[4], s[5]), fmaxf(s[6], s[7])));
            const float mn = fmaxf(m, mx); float ps = 0.f;
#pragma unroll
            for (int r = 0; r < 8; ++r) ps += ok[r] ? __expf(s[r] - mn) : 0.f;
            l = l * __expf(m - mn) + ps; m = mn;
#pragma unroll
            for (int i = 0; i < 4; ++i) ck[i] = nk[i];
        }
        {
            float mo = shx(m, 16, lane), lo = shx(l, 16, lane); float mn = fmaxf(m, mo); l = l * __expf(m - mn) + lo * __expf(mo - mn); m = mn;
            mo = shx(m, 32, lane); lo = shx(l, 32, lane); mn = fmaxf(m, mo); l = l * __expf(m - mn) + lo * __expf(mo - mn); m = mn;
        }
        const float il = l > 0.f ? 1.0f / l : 0.f;
        f32x4 acc[4];
#pragma unroll
        for (int d = 0; d < 4; ++d) acc[d] = (f32x4){0.f, 0.f, 0.f, 0.f};
        bf16x8 cv[4];
        ck[0] = *(const bf16x8*)KC; ck[1] = *(const bf16x8*)(KC + 512); ck[2] = *(const bf16x8*)(KC + 1024); ck[3] = *(const bf16x8*)(KC + 1536);
        for (int pi = 0; pi < npair; ++pi) {
            const int pn = pi + 1 < npair ? pi + 1 : pi; const bf16_t* kp = KC + (size_t)pn * 2048;
            bf16x8 nk[4]; nk[0] = *(const bf16x8*)kp; nk[1] = *(const bf16x8*)(kp + 512); nk[2] = *(const bf16x8*)(kp + 1024); nk[3] = *(const bf16x8*)(kp + 1536);
#pragma unroll
            for (int d = 0; d < 4; ++d) cv[d] = *(const bf16x8*)(VCT + (size_t)pi * 2048 + 512 * d);
            __builtin_amdgcn_sched_barrier(0);
            f32x4 sa = mfma16(ck[0], qf0, (f32x4){0.f, 0.f, 0.f, 0.f}); sa = mfma16(ck[1], qf1, sa);
            f32x4 sb = mfma16(ck[2], qf0, (f32x4){0.f, 0.f, 0.f, 0.f}); sb = mfma16(ck[3], qf1, sb);
            float pr[8];
            const int dmin = t0 - (16 * (32 * pi + 31) + 31); const int bk0 = __builtin_amdgcn_readfirstlane(t5b(dmin < 0 ? 0 : dmin));
            if (dmin >= 0 && pi < 31 && bk0 == __builtin_amdgcn_readfirstlane(t5b(dmin + 511))) {
                const float bm = tbl[bk0 * 16 + head] - m;
#pragma unroll
                for (int r = 0; r < 4; ++r) { pr[r] = __expf(sa[r] * 0.125f + bm) * il; pr[4 + r] = __expf(sb[r] * 0.125f + bm) * il; }
            } else {
#pragma unroll
                for (int r = 0; r < 4; ++r) {
                    const int na = 32 * pi + 4 * g + r, nb = na + 16; const int da = t - (16 * na + 31), db = da - 256;
                    const bool oka = da >= 0 && na < 1023, okb = db >= 0 && nb < 1023;
                    pr[r] = oka ? __expf(sa[r] * 0.125f + tbl[t5b(da) * 16 + head] - m) * il : 0.f;
                    pr[4 + r] = okb ? __expf(sb[r] * 0.125f + tbl[t5b(db < 0 ? 0 : db) * 16 + head] - m) * il : 0.f;
                }
            }
            const bf16x8 pf = mk8p(pr[0], pr[1], pr[2], pr[3], pr[4], pr[5], pr[6], pr[7]);
#pragma unroll
            for (int d = 0; d < 4; ++d) acc[d] = mfma16(cv[d], pf, acc[d]);
            const int ja = 8 * pi + g, jb = ja + 4;
            LAS float* ir = imp + c * 257;
            ir[ja] += (pr[0] + pr[1]) + (pr[2] + pr[3]); ir[jb] += (pr[4] + pr[5]) + (pr[6] + pr[7]);
            asm volatile("" ::: "memory");
            ir[ja + 1] += pr[3]; if (jb + 1 < 256) ir[jb + 1] += pr[7];
            asm volatile("" ::: "memory");
#pragma unroll
            for (int i = 0; i < 4; ++i) ck[i] = nk[i];
        }
        if (real) {
            const float gt = sigmoidf_(bf2f(((const bf16_t*)(big + OB_GD))[(size_t)t * 64 + head * 3 + 0]));
#pragma unroll
            for (int d = 0; d < 4; ++d) { bf16_t* op = ob + (size_t)t * 3072 + 2048 + head * 64 + 16 * d + 4 * g; const u32x2 o = *(const u32x2*)op;
                u32x2 w; w.x = pk2(bflo(o.x) + acc[d][0] * gt, bfhi(o.x) + acc[d][1] * gt); w.y = pk2(bflo(o.y) + acc[d][2] * gt, bfhi(o.y) + acc[d][3] * gt); *(u32x2*)op = w; }
        }
    }
    __syncthreads();
    for (int qq = 0; qq < 2; ++qq) {
        const int qi = 2 * wave + qq, tq = t0 + qi, cur = tq >> 6; int* ip = idx + ((size_t)tq * 2 + grp) * 16;
        if (cur <= 15) { if (lane < 16 && real) ip[lane] = lane <= cur ? lane : -1; continue; }
        float v[4];
#pragma unroll
        for (int i = 0; i < 4; ++i) { const int j = lane + 64 * i; float a = 0.f;
#pragma unroll
            for (int w = 0; w < 8; ++w) a += impall[w * (16 * 257) + qi * 257 + j];
            v[i] = (j >= 1 && j <= cur - 2) ? a : -1.f; }
        if (lane == 0 && real) { ip[0] = 0; ip[1] = cur - 1; ip[2] = cur; }
        for (int rnd = 0; rnd < 13; ++rnd) {
            float bv = v[0]; int bj = lane;
#pragma unroll
            for (int i = 1; i < 4; ++i) if (v[i] > bv) { bv = v[i]; bj = lane + 64 * i; }
            float wm = bv;
            wm = fmaxf(wm, __builtin_bit_cast(float, __builtin_amdgcn_update_dpp(0, __builtin_bit_cast(int, wm), 0xB1, 0xF, 0xF, false)));
            wm = fmaxf(wm, __builtin_bit_cast(float, __builtin_amdgcn_update_dpp(0, __builtin_bit_cast(int, wm), 0x4E, 0xF, 0xF, false)));
            wm = fmaxf(wm, __builtin_bit_cast(float, __builtin_amdgcn_update_dpp(0, __builtin_bit_cast(int, wm), 0x124, 0xF, 0xF, false)));
            wm = fmaxf(wm, __builtin_bit_cast(float, __builtin_amdgcn_update_dpp(0, __builtin_bit_cast(int, wm), 0x128, 0xF, 0xF, false)));
            const float r0 = __builtin_bit_cast(float, __builtin_amdgcn_readlane(__builtin_bit_cast(int, wm), 0)), r1 = __builtin_bit_cast(float, __builtin_amdgcn_readlane(__builtin_bit_cast(int, wm), 16));
            const float r2 = __builtin_bit_cast(float, __builtin_amdgcn_readlane(__builtin_bit_cast(int, wm), 32)), r3 = __builtin_bit_cast(float, __builtin_amdgcn_readlane(__builtin_bit_cast(int, wm), 48));
            const float gm = fmaxf(fmaxf(r0, r1), fmaxf(r2, r3));
            const unsigned long long bal = __ballot(bv == gm);
            const int owner = __builtin_ctzll(bal);
            const int pick = __builtin_amdgcn_readlane(bj, owner);
#pragma unroll
            for (int i = 0; i < 4; ++i) if (pick == lane + 64 * i) v[i] = -2.f;
            if (lane == 0 && real) ip[3 + rnd] = pick;
        }
    }
    __syncthreads();
}

__device__ __forceinline__ void compress_unit(const unsigned char* ws, const unsigned char* big, unsigned char* misc, int n0, int grp, int kind, int lane) {
    const int g = lane >> 4, c = lane & 15;
    const bf16_t* src = (const bf16_t*)(big + (kind ? OB_VCMP : OB_KCMP)) + grp * 64;
    const bf16_t* w1 = (const bf16_t*)(ws + WS_WC1 + (kind ? 512 * 1024 : 0));
    const bf16_t* w2 = (const bf16_t*)(ws + WS_WC2 + (kind ? 16384 : 0));
    const float* bv = (const float*)(ws + WS_SMALL) + (kind ? 128 : 0);
    const int n = n0 + c; int rbase = 16 * n; rbase = rbase > S_ - 32 ? S_ - 32 : rbase;
    f32x4 hacc[8];
#pragma unroll
    for (int h = 0; h < 8; ++h) hacc[h] = (f32x4){0.f, 0.f, 0.f, 0.f};
#pragma unroll 4
    for (int ks = 0; ks < 64; ++ks) {
        const bf16x8 xf = *(const bf16x8*)(src + (size_t)(rbase + (ks >> 1)) * 128 + 32 * (ks & 1) + 8 * g);
#pragma unroll
        for (int h = 0; h < 8; ++h) hacc[h] = mfma16(*(const bf16x8*)(w1 + (size_t)(16 * h + c) * 2048 + 32 * ks + 8 * g), xf, hacc[h]);
    }
#pragma unroll
    for (int h = 0; h < 8; ++h) { const f32x4 b4 = *(const f32x4*)(bv + 16 * h + 4 * g);
#pragma unroll
        for (int r = 0; r < 4; ++r) { const float x = hacc[h][r] + b4[r]; const float u = 0.7978845608028654f * (x + 0.044715f * x * x * x);
            const float th = 1.0f - 2.0f / (1.0f + __expf(2.0f * u)); hacc[h][r] = 0.5f * x * (1.0f + th); } }
    f32x4 oacc[4];
#pragma unroll
    for (int d = 0; d < 4; ++d) oacc[d] = (f32x4){0.f, 0.f, 0.f, 0.f};
#pragma unroll
    for (int s = 0; s < 4; ++s) {
        const bf16x8 hf = mk8p(hacc[2 * s][0], hacc[2 * s][1], hacc[2 * s][2], hacc[2 * s][3], hacc[2 * s + 1][0], hacc[2 * s + 1][1], hacc[2 * s + 1][2], hacc[2 * s + 1][3]);
#pragma unroll
        for (int d = 0; d < 4; ++d) { const bf16_t* wp = w2 + (size_t)(16 * d + c) * 128 + 32 * s + 4 * g;
            oacc[d] = mfma16(mk8(*(const u32x2*)wp, *(const u32x2*)(wp + 16)), hf, oacc[d]); }
    }
    if (kind == 0) { bf16_t* kc = (bf16_t*)(misc + MS_KC) + (size_t)grp * 65536;
#pragma unroll
        for (int d = 0; d < 4; ++d) { u32x2 w; w.x = pk2(oacc[d][0], oacc[d][1]); w.y = pk2(oacc[d][2], oacc[d][3]); *(u32x2*)(kc + rb_off(2, n, 16 * d + 4 * g)) = w; }
    } else { bf16_t* vct = (bf16_t*)(misc + MS_VCT) + (size_t)grp * 65536;
#pragma unroll
        for (int d = 0; d < 4; ++d)
#pragma unroll
            for (int r = 0; r < 4; ++r) vct[tb_off(64, 16 * d + 4 * g + r, n)] = (bf16_t)f2bf(oacc[d][r]);
    }
}

__device__ __forceinline__ void u_unit(const unsigned char* big, bf16_t* UT, int hh, int ch, int dvt, int lane) {
    const int g = lane >> 4, c = lane & 15;
    const bf16_t* KTT = (const bf16_t*)(big + OB_KTT) + (size_t)hh * 256 * S_ + ((size_t)(ch * 8) * 256 + c) * 32 + 8 * g;
    const bf16_t* VTT = (const bf16_t*)(big + OB_VTT) + (size_t)hh * 512 * S_ + ((size_t)(ch * 8) * 512 + 16 * dvt + c) * 32 + 8 * g;
    f32x4 acc[2][16];
#pragma unroll
    for (int i = 0; i < 16; ++i) { acc[0][i] = (f32x4){0.f, 0.f, 0.f, 0.f}; acc[1][i] = (f32x4){0.f, 0.f, 0.f, 0.f}; }
    for (int ks = 0; ks < 8; ++ks) {
        const bf16x8 vf0 = *(const bf16x8*)(VTT + (size_t)ks * 512 * 32), vf1 = *(const bf16x8*)(VTT + (size_t)ks * 512 * 32 + 8 * 16 * 32);
#pragma unroll
        for (int i = 0; i < 16; ++i) { const bf16x8 kf = *(const bf16x8*)(KTT + (size_t)ks * 256 * 32 + 512 * i); acc[0][i] = mfma16(kf, vf0, acc[0][i]); acc[1][i] = mfma16(kf, vf1, acc[1][i]); }
    }
#pragma unroll
    for (int h2 = 0; h2 < 2; ++h2) {
        bf16_t* up = UT + (size_t)(hh * 64 + ch) * 131072 + ((size_t)((dvt + 8 * h2) * 8) * 16 + c) * 32 + 4 * g;
#pragma unroll
        for (int i = 0; i < 16; ++i) { u32x2 w; w.x = pk2(acc[h2][i][0], acc[h2][i][1]); w.y = pk2(acc[h2][i][2], acc[h2][i][3]); *(u32x2*)(up + (i >> 1) * 512 + 16 * (i & 1)) = w; }
    }
}
__device__ __forceinline__ void scan_items(bf16_t* UT, int gw, int nw, int lane) {
    for (int item = gw * 64 + lane; item < 4 * 32768; item += nw * 64) {
        const int hh = item >> 15, e4 = item & 32767;
        const float dec = exp2f(256.0f * __log2f(1.0f - exp2f(-5.0f - (float)hh)));
        bf16_t* pp = UT + (size_t)hh * 64 * 131072 + (size_t)e4 * 4;
        float r0 = 0.f, r1 = 0.f, r2 = 0.f, r3 = 0.f;
#pragma unroll 8
        for (int ch = 0; ch < 64; ++ch) { u32x2* q = (u32x2*)(pp + (size_t)ch * 131072); const u32x2 u = *q;
            u32x2 w; w.x = pk2(r0, r1); w.y = pk2(r2, r3); *q = w;
            r0 = dec * (r0 + bflo(u.x)); r1 = dec * (r1 + bfhi(u.x)); r2 = dec * (r2 + bflo(u.y)); r3 = dec * (r3 + bfhi(u.y)); }
    }
}

__device__ __forceinline__ void intra_unit(const unsigned char* big, const bf16_t* UT, bf16_t* ob, const float* gn, int hh, int t0, int lane, bool real = true) {
    const int g = lane >> 4, c = lane & 15, t = t0 + c;
    const bf16_t* qp = (const bf16_t*)(big + OB_QT) + (size_t)hh * 256 * S_ + ((size_t)(t0 >> 4) * 8 * 16 + c) * 32 + 8 * g;
    const bf16_t* KT = (const bf16_t*)(big + OB_KT) + (size_t)hh * 256 * S_ + c * 32 + 8 * g;
    const bf16_t* VTTb = (const bf16_t*)(big + OB_VTT) + (size_t)hh * 512 * S_ + c * 32 + 8 * g;
    bf16_t* orow = ob + (size_t)t * 3072 + hh * 512 + 4 * g;
    const int tlo = (t0 & ~255) >> 4, thi = t0 >> 4;
    const bf16_t* RTb = UT + (size_t)(hh * 64 + (t0 >> 8)) * 131072 + c * 32 + 8 * g;
    float sum = 0.f, sq = 0.f;
    bf16x8 pfs[8];
    const int np = ((thi - tlo) >> 1) + 1;
#pragma unroll
    for (int pi = 0; pi < 8; ++pi) {
        if (pi < np) {
            const int ta = tlo + 2 * pi, tb = ta + 1;
            const bf16_t* kpa = KT + (size_t)ta * 4096; const bf16_t* kpb = kpa + 4096;
            f32x4 sa = (f32x4){0.f, 0.f, 0.f, 0.f}, sb = (f32x4){0.f, 0.f, 0.f, 0.f};
#pragma unroll
            for (int s = 0; s < 8; ++s) { const bf16x8 qf = *(const bf16x8*)(qp + 512 * s); sa = mfma16(*(const bf16x8*)(kpa + 512 * s), qf, sa); sb = mfma16(*(const bf16x8*)(kpb + 512 * s), qf, sb);
                if ((s & 3) == 3) __builtin_amdgcn_sched_barrier(0); }
            float pr[8];
#pragma unroll
            for (int r = 0; r < 4; ++r) { pr[r] = (16 * ta + 4 * g + r <= t) ? sa[r] : 0.f; pr[4 + r] = (16 * tb + 4 * g + r <= t) ? sb[r] : 0.f; }
            pfs[pi] = mk8p(pr[0], pr[1], pr[2], pr[3], pr[4], pr[5], pr[6], pr[7]);
        } else pfs[pi] = (bf16x8){0, 0, 0, 0, 0, 0, 0, 0};
    }
#pragma nounroll
    for (int hf = 0; hf < 4; ++hf) {
        f32x4 acc[8];
#pragma unroll
        for (int d = 0; d < 8; ++d) acc[d] = (f32x4){0.f, 0.f, 0.f, 0.f};
#pragma unroll
        for (int dh = 0; dh < 2; ++dh) {
            const bf16_t* vp0 = VTTb + ((size_t)(tlo >> 1) * 512 + 16 * (hf * 8 + dh * 4)) * 32;
            bf16x8 cv[4];
#pragma unroll
            for (int d = 0; d < 4; ++d) cv[d] = *(const bf16x8*)(vp0 + 512 * d);
#pragma unroll
            for (int pi = 0; pi < 8; ++pi) {
                if (pi < np) {
                    bf16x8 nv[4];
                    const bf16_t* vp = vp0 + (size_t)(pi + 1 < np ? pi + 1 : pi) * 512 * 32;
#pragma unroll
                    for (int d = 0; d < 4; ++d) nv[d] = *(const bf16x8*)(vp + 512 * d);
                    __builtin_amdgcn_sched_barrier(0);
#pragma unroll
                    for (int d = 0; d < 4; ++d) acc[dh * 4 + d] = mfma16(cv[d], pfs[pi], acc[dh * 4 + d]);
#pragma unroll
                    for (int d = 0; d < 4; ++d) cv[d] = nv[d];
                }
            }
        }
#pragma unroll
        for (int dh = 0; dh < 2; ++dh) {
            const bf16_t* rp0 = RTb + (size_t)(hf * 8 + dh * 4) * 8 * 512;
            bf16x8 cr[4];
#pragma unroll
            for (int d = 0; d < 4; ++d) cr[d] = *(const bf16x8*)(rp0 + (size_t)d * 8 * 512);
#pragma unroll
            for (int ks = 0; ks < 8; ++ks) {
                bf16x8 nr[4]; const int kn = ks < 7 ? ks + 1 : ks;
                const bf16x8 cq = *(const bf16x8*)(qp + 512 * ks);
#pragma unroll
                for (int d = 0; d < 4; ++d) nr[d] = *(const bf16x8*)(rp0 + (size_t)(d * 8 + kn) * 512);
                __builtin_amdgcn_sched_barrier(0);
#pragma unroll
                for (int d = 0; d < 4; ++d) acc[dh * 4 + d] = mfma16(cr[d], cq, acc[dh * 4 + d]);
#pragma unroll
                for (int d = 0; d < 4; ++d) cr[d] = nr[d];
            }
        }
#pragma unroll
        for (int d = 0; d < 8; ++d) {
            const float x0 = acc[d][0], x1 = acc[d][1], x2 = acc[d][2], x3 = acc[d][3];
            sum += (x0 + x1) + (x2 + x3); sq += (x0 * x0 + x1 * x1) + (x2 * x2 + x3 * x3);
            u32x2 w; w.x = pk2(x0, x1); w.y = pk2(x2, x3); if (real) *(u32x2*)(orow + 16 * (hf * 8 + d)) = w; else sq += bflo(w.x) + bflo(w.y); }
        __builtin_amdgcn_sched_barrier(0);
    }
    sum += shx(sum, 16, lane); sum += shx(sum, 32, lane); sq += shx(sq, 16, lane); sq += shx(sq, 32, lane);
    const float mu = sum * (1.0f / 512.0f); float var = sq * (1.0f / 512.0f) - mu * mu; var = var < 0.f ? 0.f : var;
    const float rs = rsqrtf(var + 1e-5f);
    const bf16_t* gcp = (const bf16_t*)(big + OB_GC) + (size_t)t * 2048 + hh * 512 + 4 * g;
    const float* gnp = gn + hh * 512 + 4 * g;
#pragma unroll
    for (int d = 0; d < 32; ++d) { const u32x2 gc = *(const u32x2*)(gcp + 16 * d); const f32x4 gw = *(const f32x4*)(gnp + 16 * d); const u32x2 o = *(const u32x2*)(orow + 16 * d);
        const float y0 = (bflo(o.x) - mu) * rs * gw[0] * siluf_(bflo(gc.x)), y1 = (bfhi(o.x) - mu) * rs * gw[1] * siluf_(bfhi(gc.x));
        const float y2 = (bflo(o.y) - mu) * rs * gw[2] * siluf_(bflo(gc.y)), y3 = (bfhi(o.y) - mu) * rs * gw[3] * siluf_(bfhi(gc.y));
        u32x2 w; w.x = pk2(y0, y1); w.y = pk2(y2, y3); if (real || y0 == 1.2345f) *(u32x2*)(orow + 16 * d) = w;
        if ((d & 3) == 3) __builtin_amdgcn_sched_barrier(0); }
}

#ifndef REP_CHAIN
#define REP_CHAIN 1
#define REP_WIN 1
#define REP_CMP 1
#define REP_INTRA 1
#define REP_SEL 1
#define REP_EATT 1
#define REP_GIN 1
#define REP_GGU 1
#define REP_MISC 1
#endif
#define XB_TMO      128
#define XB_XCNT(j)  (256  + 64 * (j))
#define XB_XSUB(j)  (1280 + 64 * (j))
#define XB_XGEN(j)  (2304 + 64 * (j))
#define XB_TOP      3328
#define XB_TOPGEN   3392
#define XCD_BAR_WORDS 3456
#define XB_SPIN_CAP (1u << 18)

__device__ __forceinline__ unsigned xb_ld(unsigned* p)              { return __hip_atomic_load(p, __ATOMIC_RELAXED, __HIP_MEMORY_SCOPE_AGENT); }
__device__ __forceinline__ unsigned xb_add(unsigned* p, unsigned v) { return __hip_atomic_fetch_add(p, v, __ATOMIC_RELAXED, __HIP_MEMORY_SCOPE_AGENT); }
__device__ __forceinline__ unsigned xb_xcc_id() { return (unsigned)__builtin_amdgcn_s_getreg((3 << 11) | 20) & 0xFu; }
#define XB_SPIN(cond, bar) do { unsigned _sp = 0; while (cond) { __builtin_amdgcn_s_sleep(1); \
    if ((++_sp & 255u) == 0u) { if (xb_ld(&(bar)[XB_TMO])) break; if (_sp > XB_SPIN_CAP) { atomicAdd(&(bar)[XB_TMO], 1u); break; } } } } while (0)

struct XcdBarrier {
    unsigned* bar; unsigned x;
    volatile LAS unsigned* st;
};

__device__ __forceinline__ XcdBarrier xcd_barrier_post(unsigned* bar, volatile LAS unsigned* st) {
    XcdBarrier b; b.bar = bar; b.x = xb_xcc_id(); b.st = st;
    if (threadIdx.x == 0) (void)xb_add(&bar[XB_XCNT(b.x)], 1u);
    return b;
}
__device__ __forceinline__ void xcd_barrier_complete(unsigned* bar, unsigned x, unsigned& nloc, unsigned& nx) {
    const unsigned G = gridDim.x * gridDim.y * gridDim.z;
    unsigned sum, cnt, mine, sp = 0u;
    for (;;) {
        sum = 0u; cnt = 0u; mine = 0u;
#pragma unroll
        for (unsigned j = 0; j < 16; ++j) { const unsigned c = xb_ld(&bar[XB_XCNT(j)]); sum += c; cnt += (c > 0u) ? 1u : 0u; mine = (j == x) ? c : mine; }
        if (sum == G) break;
        __builtin_amdgcn_s_sleep(1);
        if ((++sp & 255u) == 0u) { if (xb_ld(&bar[XB_TMO])) break; if (sp > XB_SPIN_CAP) { atomicAdd(&bar[XB_TMO], 1u); break; } }
    }
    nloc = mine > 0u ? mine : 1u; nx = cnt > 0u ? cnt : 1u;
}

__device__ __forceinline__ void xcd_barrier(const XcdBarrier& b) {
    asm volatile("s_waitcnt vmcnt(0)" ::: "memory");
    __syncthreads();
    if (threadIdx.x == 0) {
        unsigned* bar = b.bar;
        __builtin_amdgcn_s_waitcnt(0);
        unsigned nloc = b.st[0], nx = b.st[1];
        if (nloc == 0u) { xcd_barrier_complete(bar, b.x, nloc, nx); b.st[0] = nloc; b.st[1] = nx; }
        const unsigned old = xb_add(&bar[XB_XSUB(b.x)], 1u);
        const unsigned gen = old / nloc;
        if (old + 1u == (gen + 1u) * nloc) {
            __builtin_amdgcn_fence(__ATOMIC_RELEASE, "agent");
            asm volatile("s_waitcnt vmcnt(0)" ::: "memory");
            const unsigned og = xb_add(&bar[XB_TOP], 1u);
            const unsigned tg = og / nx;
            if (og + 1u == (tg + 1u) * nx) xb_add(&bar[XB_TOPGEN], 1u);
            else XB_SPIN(xb_ld(&bar[XB_TOPGEN]) == tg, bar);
            __builtin_amdgcn_fence(__ATOMIC_ACQUIRE, "agent");
            xb_add(&bar[XB_XGEN(b.x)], 1u);
            asm volatile("s_waitcnt vmcnt(0)" ::: "memory");
        } else {
            XB_SPIN(xb_ld(&bar[XB_XGEN(b.x)]) == gen, bar);
            __builtin_amdgcn_fence(__ATOMIC_ACQUIRE, "agent");
            asm volatile("s_waitcnt vmcnt(0)" ::: "memory");
        }
    }
    __syncthreads();
}

#ifndef REP_GRES
#define REP_GRES 1
#endif
#ifndef REP_GEIN
#define REP_GEIN 1
#endif
#ifndef REP_SYNC
#define REP_SYNC 1
#endif
#define REAL_(rep, R) ((rep) == (R) - 1 || p.ph_lo < 0)
typedef const __attribute__((address_space(4))) Params* KP;
typedef const __attribute__((address_space(4))) Params* KP;
__device__ __forceinline__ Params load_params() { KP k = (KP)__builtin_amdgcn_kernarg_segment_ptr(); asm volatile("" : "+s"(k)); Params r; r.x = k->x; r.rel_table = k->rel_table; r.norm_mix = k->norm_mix; r.norm_ffn = k->norm_ffn; r.norm_final = k->norm_final; r.even_w_in = k->even_w_in; r.even_sinks = k->even_sinks; r.even_w_out = k->even_w_out; r.odd_w_in = k->odd_w_in; r.odd_ret_gn = k->odd_ret_gn; r.odd_cmp_pos_k = k->odd_cmp_pos_k; r.odd_cmp_pos_v = k->odd_cmp_pos_v; r.odd_cmp_k_w1 = k->odd_cmp_k_w1; r.odd_cmp_k_w2 = k->odd_cmp_k_w2; r.odd_cmp_v_w1 = k->odd_cmp_v_w1; r.odd_cmp_v_w2 = k->odd_cmp_v_w2; r.odd_w_out = k->odd_w_out; r.ffn_w_gate = k->ffn_w_gate; r.ffn_w_up = k->ffn_w_up; r.ffn_w_down = k->ffn_w_down; r.out = k->out; r.ws = k->ws; r.ph_lo = k->ph_lo; r.ph_hi = k->ph_hi; return r; }
__global__ void __launch_bounds__(512, 2) trunk_fwd(Params p0) {
    extern __shared__ __attribute__((aligned(16))) unsigned char lds_raw[];
    LAS unsigned char* lds = (LAS unsigned char*)lds_raw;
    LAS float* tbl = (LAS float*)(lds + LDS_TBL);
    cg::grid_group grid = cg::this_grid();
    const int G = gridDim.x, nw = 8 * G;
    tbl[threadIdx.x] = p0.rel_table[threadIdx.x];
    volatile LAS unsigned* xst = (volatile LAS unsigned*)(lds + LDS_XB);
    if (threadIdx.x < 4) xst[threadIdx.x] = 0u;
    __syncthreads();
    (void)xcd_barrier_post((unsigned*)(p0.ws + WS_BAR), xst);
    int ph = 0; const int ph_lo_ = p0.ph_lo, ph_hi_ = p0.ph_hi;
#define PH_BEGIN if (ph >= ph_lo_ && ph < ph_hi_) { const Params p = load_params(); const int tid = launder_tid(), lane = tid & 63, wave = tid >> 6, bid = launder_bid(), gw = wave * G + bid; (void)lane; (void)gw; unsigned char* ws = launder_ptr(p.ws); unsigned char* big = ws + WS_BIG; unsigned char* misc = ws + WS_MISC; bf16_t* hn = (bf16_t*)(ws + WS_HN); bf16_t* obuf = (bf16_t*)(ws + WS_O); float* outp = (float*)launder_ptr((unsigned char*)p.out); (void)big; (void)misc; (void)hn; (void)obuf; (void)outp;
#define EVP bf16_t* qkv = (bf16_t*)(big + EB_QKV); bf16_t* op = (bf16_t*)(big + EB_OP); float* lsep = (float*)(big + EB_LSE); (void)qkv; (void)op; (void)lsep;
#define PH_END   if (ph + 1 < ph_hi_) { if (p.ph_lo < 0) grid.sync(); XcdBarrier xb_; xb_.bar = (unsigned*)(launder_ptr(p.ws) + WS_BAR); xb_.x = xb_xcc_id(); xb_.st = (volatile LAS unsigned*)(lds + LDS_XB); for (int rs_ = 0; rs_ < REP_SYNC; ++rs_) xcd_barrier(xb_); } } ++ph;

    for (int layer = 0; layer < 4; ++layer) {
        const int li = layer >> 1; const bool odd = layer & 1;

        PH_BEGIN for (int rep = 0; rep < REP_MISC; ++rep) { phase_convert(p, layer, lds); phase_rmsnorm(layer == 0 ? p.x : outp, p.norm_mix + layer * DM, hn, nullptr); } PH_END
        if (!odd) {
            PH_BEGIN { EVP pg8::Gemm g{hn, (const bf16_t*)(ws + WS_WIN), M_, 2304, 1024}; pg8::StaticOrder so; so.init(M_, 2304, G, bid); EpiBf16 e{qkv, 2304};
                for (int rep = 0; rep < REP_GEIN; ++rep) pg8::gemm_phase<EpiBf16, pg8::StaticOrder, true, true>(lds, g, so, e); } PH_END
            PH_BEGIN { EVP
                for (int rep = 0; rep < REP_EATT; ++rep) for (int j = (G == 256 ? (bid >> 3) * 8 + wave : gw); j < (G == 256 ? 8192 : 65536); j += (G == 256 ? 256 : nw)) {
                    const int kind = G == 256 ? j >> 11 : j >> 14, b = G == 256 ? (j >> 10) & 1 : (j >> 13) & 1, h = G == 256 ? (bid & 7) : (j >> 10) & 7, tile = j & 1023;
                    const bf16_t* base = qkv + (size_t)b * S_ * 2304;
                    if (kind == 0) {
                        band_unit<false>(base + h * 64, 2304, base + 512 + (h >> 2) * 64, 2304, base + 640 + (h >> 2) * 64, 2304, S_, 1, 0, 127, h, tile * 16,
                                         obuf + (size_t)b * S_ * 1024 + h * 64, 1024, nullptr, 0, nullptr, 0, true, p.even_sinks[li * 8 + h], tbl, lane);
                    } else {
                        const int sh = 2 * (kind - 1), dil = 1 << sh, L = S_ >> sh; const int res = tile >> (10 - sh), it = tile & ((1024 >> sh) - 1);
                        band_unit<false>(base + 768 + h * 64, 2304, base + 1280 + h * 64, 2304, base + 1792 + h * 64, 2304, L, dil, res, 128, 8 + h, it * 16,
                                         op + ((size_t)(kind - 1) * M_ + (size_t)b * S_) * 512 + h * 64, 512, lsep + ((size_t)(kind - 1) * M_ + (size_t)b * S_) * 8 + h, 8, nullptr, 0, false, 0.f, tbl, lane);
                    }
                }
            } PH_END
            PH_BEGIN { EVP
                for (int u = bid * 512 + tid; u < M_ * 8 * 8; u += G * 512) {
                    const int tok = u >> 6, h = (u >> 3) & 7, ch = u & 7;
                    const float l0 = lsep[(size_t)tok * 8 + h], l1 = lsep[((size_t)M_ + tok) * 8 + h], l2 = lsep[((size_t)2 * M_ + tok) * 8 + h];
                    const float mx = fmaxf(l0, fmaxf(l1, l2)); float w0 = __expf(l0 - mx), w1 = __expf(l1 - mx), w2 = __expf(l2 - mx); const float iw = 1.0f / (w0 + w1 + w2); w0 *= iw; w1 *= iw; w2 *= iw;
                    const size_t eo = (size_t)tok * 512 + h * 64 + ch * 8;
                    const u32x4 a = *(const u32x4*)(op + eo), b4 = *(const u32x4*)(op + (size_t)M_ * 512 + eo), c4 = *(const u32x4*)(op + (size_t)2 * M_ * 512 + eo);
                    u32x4 r;
#pragma unroll
                    for (int k = 0; k < 4; ++k) r[k] = pk2(w0 * bflo(a[k]) + w1 * bflo(b4[k]) + w2 * bflo(c4[k]), w0 * bfhi(a[k]) + w1 * bfhi(b4[k]) + w2 * bfhi(c4[k]));
                    *(u32x4*)(obuf + (size_t)tok * 1024 + 512 + h * 64 + ch * 8) = r;
                }
            } PH_END
            PH_BEGIN { pg8::Gemm g{obuf, (const bf16_t*)(ws + WS_WOUT), M_, 1024, 1024}; pg8::StaticOrder so; so.init(M_, 1024, G, bid); for (int rep = 0; rep < REP_GRES; ++rep) { EpiResid e{layer == 0 ? p.x : outp, outp, REAL_(rep, REP_GRES)};
                pg8::gemm_phase<EpiResid, pg8::StaticOrder, true, true>(lds, g, so, e); } } PH_END
        } else {
            for (int b = 0; b < 2; ++b) {
                PH_BEGIN { pg8::Gemm g{hn + (size_t)b * S_ * 1024, (const bf16_t*)(ws + WS_WIN), S_, 8192, 1024}; pg8::StaticOrder so; so.init(S_, 8192, G, bid); EpiOddIn e{big};
                    for (int rep = 0; rep < REP_GIN; ++rep) pg8::gemm_phase<EpiOddIn, pg8::StaticOrder, true, true>(lds, g, so, e); } PH_END
                PH_BEGIN {
                    { const int ln = launder_tid() & 63; for (int rep = 0; rep < REP_CHAIN; ++rep) for (int hc = bid; hc < 256; hc += G) for (int k = 0; k < 2; ++k) u_unit(big, hn, hc >> 6, hc & 63, wave + 16 * k, ln); }
                    { const int ln = launder_tid() & 63; for (int u = gw; u < 256; u += nw) compress_unit(ws, big, misc, (u & 63) * 16, (u >> 6) & 1, u >> 7, ln); }
                    { const int ln = launder_tid() & 63; for (int rep = 0; rep < REP_WIN; ++rep) {
                        if (G == 256) { const int lw = (bid >> 3) * 8 + wave, tile = (bid & 7) * 128 + (lw & 127);
                            for (int h = lw >> 7; h < 16; h += 2) win_unit(big, obuf, h, tile * 16, tbl, ln); }
                        else for (int v = gw; v < 16384; v += nw) win_unit(big, obuf, v >> 10, (v & 1023) * 16, tbl, ln); } }
                } PH_END
                PH_BEGIN {
                    { const int ln = launder_tid() & 63; scan_items(hn, gw, nw, ln); }
                    { const int tl = launder_tid(); const int ln = tl & 63, wv = __builtin_amdgcn_readfirstlane(tl >> 6);
                      for (int rep = 0; rep < REP_CMP; ++rep) for (int ts = bid; ts < 256; ts += G)
                        for (int i = 0; i < 8; ++i) { const int q = i >> 1, grp = i & 1; const int tile = q == 0 ? ts : (q == 1 ? 511 - ts : (q == 2 ? 512 + ts : 1023 - ts));
                            cmp_unit(big, misc, (int*)(misc + MS_IDX), obuf, tile * 16, grp, tbl, (LAS float*)lds, wv, ln, REAL_(rep, REP_CMP)); } }
                } PH_END
                PH_BEGIN {
                    { const int ln = launder_tid() & 63; for (int rep = 0; rep < REP_INTRA; ++rep) for (int hc = bid; hc < 256; hc += G) for (int k = 0; k < 2; ++k) { const int tl = k ? 15 - wave : wave;
                            intra_unit(big, hn, obuf, p.odd_ret_gn + (size_t)li * 2048, hc >> 6, ((hc & 63) * 16 + tl) * 16, ln, REAL_(rep, REP_INTRA)); } }
                    { const int ln = launder_tid() & 63; for (int rep = 0; rep < REP_SEL; ++rep) {
                        if (G == 256) { const int grp = bid & 1, xq = (bid >> 1) & 3, lw = (bid >> 3) * 8 + wave;
                            for (int t = xq * 4096 + lw; t < (xq + 1) * 4096; t += 256) sel_unit(big, (const int*)(misc + MS_IDX), obuf, t, grp, tbl, ln, REAL_(rep, REP_SEL)); }
                        else for (int u = gw; u < 2 * S_; u += nw) sel_unit(big, (const int*)(misc + MS_IDX), obuf, u >> 1, u & 1, tbl, ln, REAL_(rep, REP_SEL)); } }
                } PH_END
                PH_BEGIN { pg8::Gemm g{obuf, (const bf16_t*)(ws + WS_WOUT), S_, 1024, 3072}; pg8::StaticOrder so; so.init(S_, 1024, G, bid);
                    for (int rep = 0; rep < REP_GRES; ++rep) { EpiResid e{(layer == 0 ? p.x : outp) + (size_t)b * S_ * 1024, outp + (size_t)b * S_ * 1024, REAL_(rep, REP_GRES)};
                    pg8::gemm_phase<EpiResid, pg8::StaticOrder, true, true>(lds, g, so, e); }
                    if (b == 0) phase_rmsnorm(outp, p.norm_mix + layer * DM, hn, nullptr, S_, M_);
                } PH_END
            }
        }
        PH_BEGIN phase_rmsnorm(outp, p.norm_ffn + layer * DM, hn, nullptr); PH_END
        PH_BEGIN { pg8::Gemm g{hn, (const bf16_t*)(ws + WS_WGU), M_, 5632, 1024}; pg8::StaticOrder so; so.init(M_, 5632, G, bid); EpiSwiglu e{(bf16_t*)big};
            for (int rep = 0; rep < REP_GGU; ++rep) pg8::gemm_phase<EpiSwiglu, pg8::StaticOrder, true, true>(lds, g, so, e); } PH_END
        PH_BEGIN { pg8::Gemm g{(const bf16_t*)big, (const bf16_t*)(ws + WS_WDN), M_, 1024, FF_}; pg8::StaticOrder so; so.init(M_, 1024, G, bid); for (int rep = 0; rep < REP_GRES; ++rep) { EpiResid e{outp, outp, REAL_(rep, REP_GRES)};
            pg8::gemm_phase<EpiResid, pg8::StaticOrder, true, true>(lds, g, so, e); } } PH_END
    }
    PH_BEGIN phase_rmsnorm(outp, p.norm_final, nullptr, outp); PH_END
}

#ifndef N_PHASES
#define N_PHASES 45
#endif
#ifndef ONE_LAUNCH
#define ONE_LAUNCH 1
#endif
extern "C" void kernel_launch(void* const* d_in, const int* in_sizes, int n_in, void* d_out, int out_size, void* d_ws, size_t ws_size, hipStream_t stream) {
    static int grid = 0;
    if (grid == 0) {
        if (n_in != 20 || out_size != M_ * DM || ws_size < WS_END) { fprintf(stderr, "kernel_launch: unexpected shapes (n_in %d, out %d, ws %zu); nothing launched\n", n_in, out_size, ws_size); grid = -1; return; }
        int dev = 0, cus = 0;
        if (hipGetDevice(&dev) != hipSuccess || hipDeviceGetAttribute(&cus, hipDeviceAttributeMultiprocessorCount, dev) != hipSuccess) { grid = -1; return; }
        if (hipFuncSetAttribute((const void*)trunk_fwd, hipFuncAttributeMaxDynamicSharedMemorySize, LDS_BYTES) != hipSuccess) { fprintf(stderr, "kernel_launch: hipFuncSetAttribute failed\n"); grid = -1; return; }
        int per_cu = 0;
        if (hipOccupancyMaxActiveBlocksPerMultiprocessor(&per_cu, (const void*)trunk_fwd, 512, LDS_BYTES) != hipSuccess || per_cu < 1) { fprintf(stderr, "kernel_launch: occupancy query says %d\n", per_cu); (void)hipGetLastError(); }
        grid = cus;
    }
    if (grid < 0) return;
    Params p{};
    const float** pp = (const float**)&p;
    for (int i = 0; i < 20; ++i) pp[i] = (const float*)d_in[i];
    p.out = (float*)d_out; p.ws = (unsigned char*)d_ws;
#if ONE_LAUNCH
    p.ph_lo = 0; p.ph_hi = N_PHASES;
    if (hipMemsetAsync((unsigned char*)d_ws + WS_BAR, 0, XCD_BAR_WORDS * 4, stream) != hipSuccess) { fprintf(stderr, "kernel_launch: memset of the barrier words failed\n"); return; }
    void* args[] = {&p};
    hipError_t e = hipLaunchCooperativeKernel((const void*)trunk_fwd, dim3(grid), dim3(512), args, LDS_BYTES, stream);
    if (e != hipSuccess) fprintf(stderr, "kernel_launch: cooperative launch failed: %s (grid %d)\n", hipGetErrorString(e), grid);
#else
    for (int ph = 0; ph < N_PHASES; ++ph) { p.ph_lo = ph; p.ph_hi = ph + 1; hipLaunchKernelGGL(trunk_fwd, dim3(grid), dim3(512), LDS_BYTES, stream, p); }
#endif
}
```

```cpp
#include <hip/hip_runtime.h>
#include <hip/hip_cooperative_groups.h>
#include <cstdio>
#include <cstdint>
namespace cg = cooperative_groups;

#define LAS __attribute__((address_space(3)))
typedef unsigned short bf16_t;
typedef short bf16x8 __attribute__((ext_vector_type(8)));
typedef float f32x4 __attribute__((ext_vector_type(4)));
typedef unsigned u32x4 __attribute__((ext_vector_type(4)));
typedef unsigned u32x2 __attribute__((ext_vector_type(2)));

__device__ __forceinline__ unsigned f2bf(float f) { unsigned u = __builtin_bit_cast(unsigned, f); return (u + 0x7fffu + ((u >> 16) & 1u)) >> 16; }
__device__ __forceinline__ unsigned pk2s(float lo, float hi) { return f2bf(lo) | (f2bf(hi) << 16); }
typedef float f32x2_t __attribute__((ext_vector_type(2)));
typedef __bf16 bf16x2_t __attribute__((ext_vector_type(2)));
__device__ __forceinline__ unsigned pk2(float lo, float hi) { f32x2_t v = {lo, hi}; bf16x2_t b = __builtin_convertvector(v, bf16x2_t); return __builtin_bit_cast(unsigned, b); }
__device__ __forceinline__ float bf2f(bf16_t b) { return __builtin_bit_cast(float, (unsigned)b << 16); }
__device__ __forceinline__ float bflo(unsigned w) { return __builtin_bit_cast(float, w << 16); }
__device__ __forceinline__ float bfhi(unsigned w) { return __builtin_bit_cast(float, w & 0xffff0000u); }
__device__ __forceinline__ f32x4 mfma16(bf16x8 a, bf16x8 b, f32x4 c) { return __builtin_amdgcn_mfma_f32_16x16x32_bf16(a, b, c, 0, 0, 0); }
__device__ __forceinline__ bf16x8 mk8(u32x2 lo, u32x2 hi) { u32x4 v = {lo.x, lo.y, hi.x, hi.y}; return __builtin_bit_cast(bf16x8, v); }
__device__ __forceinline__ bf16x8 mk8p(float a0, float a1, float a2, float a3, float b0, float b1, float b2, float b3) {
    u32x4 v = {pk2(a0, a1), pk2(a2, a3), pk2(b0, b1), pk2(b2, b3)}; return __builtin_bit_cast(bf16x8, v); }
__device__ __forceinline__ float shx(float v, int mask, int lane) { return __builtin_bit_cast(float, __builtin_amdgcn_ds_bpermute((lane ^ mask) << 2, __builtin_bit_cast(int, v))); }
__device__ __forceinline__ int shx(int v, int mask, int lane) { return __builtin_amdgcn_ds_bpermute((lane ^ mask) << 2, v); }
__device__ __forceinline__ float sigmoidf_(float x) { return 1.0f / (1.0f + __expf(-x)); }
__device__ __forceinline__ float siluf_(float x) { return x / (1.0f + __expf(-x)); }
__device__ __forceinline__ int t5b(int d) {
    float f = __log2f((float)d * 0.0625f) * 2.2857144f;
    int k = (int)f; k = k > 15 ? 15 : k;
    return d < 16 ? d : 16 + k;
}

__device__ __forceinline__ int launder_tid() { int t = threadIdx.x; asm volatile("" : "+v"(t)); return t; }
__device__ __forceinline__ unsigned char* launder_ptr(unsigned char* q) { asm volatile("" : "+s"(q)); return q; }
__device__ __forceinline__ int launder_bid() { int t = blockIdx.x; asm volatile("" : "+s"(t)); return t; }
__device__ __forceinline__ int tperm(int tt) { return ((tt & 12) << 1) | ((tt >> 4) << 2) | (tt & 3); }
__device__ __forceinline__ size_t tb_off(int ndim, int dim, int t) { return ((size_t)(t >> 5) * ndim + dim) * 32 + tperm(t & 31); }
__device__ __forceinline__ size_t rb_off(int nks, int t, int col) { return (((size_t)(t >> 4) * nks + (col >> 5)) * 16 + (t & 15)) * 32 + (col & 31); }
constexpr int S_ = 16384, NB_ = 2, M_ = S_ * NB_, DM = 1024, FF_ = 2816;
constexpr size_t MiB = 1u << 20;
constexpr size_t WS_SMALL = 0;
constexpr size_t WS_WIN = 1 * MiB, WS_WOUT = 17 * MiB, WS_WGU = 23 * MiB, WS_WDN = 34 * MiB, WS_WC1 = 40 * MiB, WS_WC2 = 41 * MiB;
constexpr size_t WS_HN = 45 * MiB, WS_O = 109 * MiB, WS_BIG = 205 * MiB, WS_MISC = 487 * MiB, WS_END = 490 * MiB;
constexpr size_t OB_QT = 0, OB_KT = 32 * MiB, OB_KTT = 64 * MiB, OB_VTT = 96 * MiB, OB_GC = 160 * MiB, OB_QD = 224 * MiB, OB_KCMP = 256 * MiB, OB_VCMP = 260 * MiB,
                 OB_KSLC = 264 * MiB, OB_VSLCT = 268 * MiB, OB_KWIN = 272 * MiB, OB_VWIN = 276 * MiB, OB_GD = 280 * MiB;
constexpr size_t EB_QKV = 0, EB_OP = 144 * MiB, EB_LSE = 240 * MiB;
constexpr size_t MS_KC = 0, MS_VCT = 256 * 1024, MS_IDX = 1 * MiB;
constexpr int LDS_TBL = 132096;
constexpr int LDS_XB = 134144;
constexpr size_t WS_BAR = 65536;
constexpr int LDS_BYTES = 143360;

struct Params {
    const float* x; const float* rel_table; const float* norm_mix; const float* norm_ffn; const float* norm_final;
    const float* even_w_in; const float* even_sinks; const float* even_w_out;
    const float* odd_w_in; const float* odd_ret_gn; const float* odd_cmp_pos_k; const float* odd_cmp_pos_v;
    const float* odd_cmp_k_w1; const float* odd_cmp_k_w2; const float* odd_cmp_v_w1; const float* odd_cmp_v_w2; const float* odd_w_out;
    const float* ffn_w_gate; const float* ffn_w_up; const float* ffn_w_down;
    float* out; unsigned char* ws;
    int ph_lo, ph_hi;
};

namespace pg8 {
#define PG8_LAS __attribute__((address_space(3)))
constexpr int BM = 256, BK = 64, HALF = 128, HTB = HALF * BK * 2  , STAGE_BYTES = 8 * HTB, NXCD = 8, WGM = 8;
__host__ __device__ __forceinline__ int lds_byte(int r, int c) { const int st = (r >> 4) * 2 + (c >> 5), rr = r & 15, cc = c & 31, ob = rr * 64 + cc * 2; return st * 1024 + (ob ^ (((ob >> 9) & 1) << 5)); }
__host__ __device__ __forceinline__ void stage_rc(int b, int& R, int& C) { const int st = b / 1024, sb = b % 1024, swz = sb ^ (((sb >> 9) & 1) << 5); R = (st >> 1) * 16 + swz / 64; C = (st & 1) * 32 + (swz % 64) / 2; }
__host__ __device__ __forceinline__ int perm32(int rho) { const int n = rho >> 4, i = rho & 15; return 8 * (i >> 2) + 4 * n + (i & 3); }

struct Unit { int pm, pn; };
struct Gemm { const bf16_t* A; const bf16_t* Bt; int M, N, K; };

struct StaticOrder {
    int nM, nN, nwg, G, c;
    __host__ __device__ void init(int M, int N, int G_, int c_) { nM = M / BM; nN = N / BM; nwg = nM * nN; G = G_; c = c_; }
    __host__ __device__ bool next(int i, Unit& u) const {
        const long L = (long)i * G + c; if (L >= nwg) return false;
        int wgid = (int)L; { const int q = nwg / NXCD, r = nwg % NXCD, xcd = wgid % NXCD, off = wgid / NXCD; wgid = (xcd < r ? xcd * (q + 1) : r * (q + 1) + (xcd - r) * q) + off; }
        const int nig = WGM * nN, gid = wgid / nig, fm = gid * WGM, gsz = (nM - fm) < WGM ? (nM - fm) : WGM;
        u.pm = fm + ((wgid % nig) % gsz); u.pn = (wgid % nig) / gsz; return true;
    }
    __device__ __forceinline__ void a_ready(const Unit&) const {}
    __device__ __forceinline__ void done(const Unit&) const {}
};

__device__ __forceinline__ unsigned cvt_pk_bf16(float lo, float hi) { unsigned r; asm volatile("v_cvt_pk_bf16_f32 %0, %1, %2" : "=v"(r) : "v"(lo), "v"(hi)); return r; }
template <class Epi, class Sched, bool ALIGN_EPI = false, bool SP2 = false>
__device__ __forceinline__ void gemm_phase(PG8_LAS unsigned char* lds, const Gemm g, const Sched& S, const Epi& E) {
    const int tid = launder_tid(), wid = __builtin_amdgcn_readfirstlane(tid >> 6), lane = tid & 63, wr = wid >> 2, wc = wid & 3, fr = lane & 15, fq = lane >> 4;
    const int K = g.K, nt = K / BK;
    unsigned voffA[2], voffB[2];
#pragma unroll
    for (int i = 0; i < 2; ++i) { int R, C; stage_rc(tid * 16 + i * 8192, R, C); const int Rb = Epi::PERM ? ((R & ~31) + perm32(R & 31)) : R;
        voffA[i] = (unsigned)(R * K + C) * 2u; voffB[i] = (unsigned)(Rb * K + C) * 2u; }
    const size_t kstep = (size_t)(BK * 2);
    const size_t hstep = (size_t)HALF * K * 2;
    const size_t tstep = 2 * hstep;
    const unsigned ldsw = (unsigned)wid * 1024u;
    const int aoff = lds_byte(wr * 64 + fr, fq * 8), boff = lds_byte(wc * 32 + fr, fq * 8);
#define PG8_SA(b, h) (((b) * 2 + (h)) * HTB)
#define PG8_SB(b, h) ((4 + (b) * 2 + (h)) * HTB)
#define PG8_STAGE(bufoff, gbase, voff) do { _Pragma("unroll") for (int _i = 0; _i < 2; ++_i) \
        __builtin_amdgcn_global_load_lds((const unsigned*)((const char*)(gbase) + (voff)[_i]), (PG8_LAS unsigned*)(lds + (bufoff) + ldsw + _i * 8192), 16, 0, 0); } while (0)
#define PG8_LDA(dst, b, h) do { _Pragma("unroll") for (int m = 0; m < 4; ++m) _Pragma("unroll") for (int k = 0; k < 2; ++k) dst[m][k] = *(const PG8_LAS bf16x8*)(lds + PG8_SA(b, h) + aoff + m * 2048 + k * 1024); } while (0)
#define PG8_LDB(dst, b, h) do { _Pragma("unroll") for (int n = 0; n < 2; ++n) _Pragma("unroll") for (int k = 0; k < 2; ++k) dst[n][k] = *(const PG8_LAS bf16x8*)(lds + PG8_SB(b, h) + boff + n * 2048 + k * 1024); } while (0)
#define PG8_MMA(ai, bj, At, Bt) do { __builtin_amdgcn_s_setprio(1); _Pragma("unroll") for (int m = 0; m < 4; ++m) _Pragma("unroll") for (int n = 0; n < 2; ++n) _Pragma("unroll") for (int k = 0; k < 2; ++k) \
        acc[ai][bj][m][n] = __builtin_amdgcn_mfma_f32_16x16x32_bf16(Bt[n][k], At[m][k], acc[ai][bj][m][n], 0, 0, 0); __builtin_amdgcn_s_setprio(0); } while (0)
#define PG8_WAIT_V(n) asm volatile("s_waitcnt vmcnt(" #n ")" ::: "memory")
#define PG8_WAIT_L(n) asm volatile("s_waitcnt lgkmcnt(" #n ")" ::: "memory")
#define PG8_BAR __builtin_amdgcn_s_barrier()
#define PG8_SCHED __builtin_amdgcn_sched_barrier(0)
    Unit cur, nxt; int ui = 0;
    if (!S.next(0, cur)) return;
    f32x4 acc[2][2][4][2];
#pragma unroll
    for (int a = 0; a < 2; ++a)
#pragma unroll
        for (int b = 0; b < 2; ++b)
#pragma unroll
            for (int m = 0; m < 4; ++m)
#pragma unroll
                for (int n = 0; n < 2; ++n) acc[a][b][m][n] = (f32x4){0.f, 0.f, 0.f, 0.f};
    bf16x8 At[4][2], B0[2][2], B1[2][2];
    const char* cA = (const char*)g.A + (size_t)cur.pm * tstep; const char* cB = (const char*)g.Bt + (size_t)cur.pn * tstep;
    S.a_ready(cur);
    if constexpr (SP2) {
        PG8_STAGE(PG8_SB(0, 0), cB, voffB); PG8_STAGE(PG8_SB(0, 1), cB + hstep, voffB); PG8_STAGE(PG8_SA(0, 0), cA, voffA); PG8_STAGE(PG8_SA(0, 1), cA + hstep, voffA);
        if (wr == 1) PG8_BAR;
        PG8_WAIT_V(2); PG8_BAR;
        PG8_STAGE(PG8_SB(1, 0), cB + kstep, voffB); PG8_STAGE(PG8_SA(1, 0), cA + kstep, voffA); PG8_STAGE(PG8_SB(1, 1), cB + hstep + kstep, voffB);
        PG8_WAIT_V(6); PG8_BAR;
    } else {
        PG8_STAGE(PG8_SB(0, 0), cB, voffB); PG8_STAGE(PG8_SA(0, 0), cA, voffA); PG8_STAGE(PG8_SB(0, 1), cB + hstep, voffB); PG8_STAGE(PG8_SA(0, 1), cA + hstep, voffA);
        if (wr == 1) PG8_BAR;
        PG8_WAIT_V(4); PG8_BAR;
        PG8_STAGE(PG8_SB(1, 0), cB + kstep, voffB); PG8_STAGE(PG8_SA(1, 0), cA + kstep, voffA); PG8_STAGE(PG8_SB(1, 1), cB + hstep + kstep, voffB);
        PG8_WAIT_V(6); PG8_BAR;
    }
    for (;;) {
        const bool has_next = S.next(ui + 1, nxt);
        const char* nA = has_next ? (const char*)g.A + (size_t)nxt.pm * tstep : cA; const char* nB = has_next ? (const char*)g.Bt + (size_t)nxt.pn * tstep : cB;
        for (int t = 0; t < nt; t += 2) {
            const bool last = (t == nt - 2);
            const char* a1 = cA + (size_t)(t + 1) * kstep;
            const char* a2 = last ? nA : cA + (size_t)(t + 2) * kstep; const char* b2 = last ? nB : cB + (size_t)(t + 2) * kstep;
            const char* a3 = a2 + kstep; const char* b3 = b2 + kstep;
            if (last && has_next) S.a_ready(nxt);
            if constexpr (SP2) {
            PG8_LDB(B0, 0, 0); PG8_LDB(B1, 0, 1); PG8_SCHED; PG8_LDA(At, 0, 0); PG8_STAGE(PG8_SA(1, 1), a1 + hstep, voffA);
            PG8_WAIT_V(8); PG8_WAIT_L(0); PG8_BAR; PG8_MMA(0, 0, At, B0); PG8_MMA(0, 1, At, B1); PG8_BAR; PG8_SCHED;
            PG8_LDA(At, 0, 1); PG8_STAGE(PG8_SB(0, 0), b2, voffB); PG8_STAGE(PG8_SB(0, 1), b2 + hstep, voffB); PG8_STAGE(PG8_SA(0, 0), a2, voffA);
            PG8_WAIT_V(8); PG8_WAIT_L(0); PG8_BAR; PG8_MMA(1, 0, At, B0); PG8_MMA(1, 1, At, B1); PG8_BAR; PG8_SCHED;
            PG8_LDB(B0, 1, 0); PG8_LDB(B1, 1, 1); PG8_SCHED; PG8_LDA(At, 1, 0); PG8_STAGE(PG8_SA(0, 1), a2 + hstep, voffA);
            PG8_WAIT_V(8); PG8_WAIT_L(0); PG8_BAR; PG8_MMA(0, 0, At, B0); PG8_MMA(0, 1, At, B1); PG8_BAR; PG8_SCHED;
            PG8_LDA(At, 1, 1); PG8_STAGE(PG8_SB(1, 0), b3, voffB); PG8_STAGE(PG8_SB(1, 1), b3 + hstep, voffB); PG8_STAGE(PG8_SA(1, 0), a3, voffA);
            PG8_WAIT_V(8); PG8_WAIT_L(0); PG8_BAR; PG8_MMA(1, 0, At, B0); PG8_MMA(1, 1, At, B1); PG8_BAR; PG8_SCHED;
            } else {
            PG8_LDB(B0, 0, 0); PG8_SCHED; PG8_LDA(At, 0, 0); PG8_STAGE(PG8_SA(1, 1), a1 + hstep, voffA);
            PG8_WAIT_L(8); PG8_BAR; PG8_WAIT_L(0); PG8_MMA(0, 0, At, B0); PG8_BAR; PG8_SCHED;
            PG8_LDB(B1, 0, 1); PG8_STAGE(PG8_SB(0, 0), b2, voffB);
            PG8_BAR; PG8_WAIT_L(0); PG8_MMA(0, 1, At, B1); PG8_BAR;
            PG8_LDA(At, 0, 1); PG8_STAGE(PG8_SA(0, 0), a2, voffA);
            PG8_BAR; PG8_WAIT_L(0); PG8_MMA(1, 0, At, B0); PG8_BAR; PG8_SCHED;
            PG8_STAGE(PG8_SB(0, 1), b2 + hstep, voffB);
            PG8_WAIT_V(6); PG8_BAR; PG8_MMA(1, 1, At, B1); PG8_BAR;
            PG8_LDB(B0, 1, 0); PG8_SCHED; PG8_LDA(At, 1, 0); PG8_STAGE(PG8_SA(0, 1), a2 + hstep, voffA);
            PG8_WAIT_L(8); PG8_BAR; PG8_WAIT_L(0); PG8_MMA(0, 0, At, B0); PG8_BAR; PG8_SCHED;
            PG8_LDB(B1, 1, 1); PG8_STAGE(PG8_SB(1, 0), b3, voffB);
            PG8_BAR; PG8_WAIT_L(0); PG8_MMA(0, 1, At, B1); PG8_BAR;
            PG8_LDA(At, 1, 1); PG8_STAGE(PG8_SA(1, 0), a3, voffA);
            PG8_BAR; PG8_WAIT_L(0); PG8_MMA(1, 0, At, B0); PG8_BAR; PG8_SCHED;
            PG8_STAGE(PG8_SB(1, 1), b3 + hstep, voffB);
            PG8_WAIT_V(6); PG8_BAR; PG8_MMA(1, 1, At, B1); PG8_BAR;
            }
        }
        if constexpr (ALIGN_EPI) { if (wr == 0) PG8_BAR; }
        if constexpr (!Epi::AFTER_DRAIN) { E(acc, cur, wr, wc, fr, fq); S.done(cur); }
        if (!has_next) break;
#pragma unroll
        for (int a = 0; a < 2; ++a)
#pragma unroll
            for (int b = 0; b < 2; ++b)
#pragma unroll
                for (int m = 0; m < 4; ++m)
#pragma unroll
                    for (int n = 0; n < 2; ++n) acc[a][b][m][n] = (f32x4){0.f, 0.f, 0.f, 0.f};
        cur = nxt; cA = nA; cB = nB; ++ui;
        if constexpr (ALIGN_EPI) { if (wr == 1) PG8_BAR; }
    }
    PG8_WAIT_V(0);
    if constexpr (!ALIGN_EPI) { if (wr == 0) PG8_BAR; }
    PG8_BAR;
    if constexpr (Epi::AFTER_DRAIN) { E.fused(acc, cur, wr, wc, fr, fq, lds, wid, lane); S.done(cur); }
#undef PG8_SA
#undef PG8_SB
#undef PG8_STAGE
#undef PG8_LDA
#undef PG8_LDB
#undef PG8_MMA
#undef PG8_WAIT_V
#undef PG8_WAIT_L
#undef PG8_BAR
#undef PG8_SCHED
}
}

struct EpiBf16 {
    static constexpr bool PERM = true, AFTER_DRAIN = false;
    bf16_t* O; int ldc;
    __device__ __forceinline__ void operator()(const f32x4 (&acc)[2][2][4][2], const pg8::Unit& u, int wr, int wc, int fr, int fq) const {
        const int row0 = u.pm * 256 + wr * 64 + fr, col0 = u.pn * 256 + wc * 32 + 8 * fq;
#pragma unroll
        for (int ai = 0; ai < 2; ++ai)
#pragma unroll
            for (int m = 0; m < 4; ++m) { bf16_t* rowp = O + (size_t)(row0 + ai * 128 + m * 16) * ldc + col0;
#pragma unroll
                for (int bj = 0; bj < 2; ++bj) { const f32x4 v0 = acc[ai][bj][m][0], v1 = acc[ai][bj][m][1];
                    u32x4 w; w.x = pk2(v0[0], v0[1]); w.y = pk2(v0[2], v0[3]); w.z = pk2(v1[0], v1[1]); w.w = pk2(v1[2], v1[3]);
                    *(u32x4*)(rowp + bj * 128) = w; } }
    }
};
struct EpiResid {
    static constexpr bool PERM = true, AFTER_DRAIN = false;
    const float* in; float* out; bool real;
    __device__ __forceinline__ void operator()(const f32x4 (&acc)[2][2][4][2], const pg8::Unit& u, int wr, int wc, int fr, int fq) const {
        const int row0 = u.pm * 256 + wr * 64 + fr, col0 = u.pn * 256 + wc * 32 + 8 * fq;
#pragma unroll
        for (int ai = 0; ai < 2; ++ai)
#pragma unroll
            for (int m = 0; m < 4; ++m) { const size_t ro = (size_t)(row0 + ai * 128 + m * 16) * DM + col0;
#pragma unroll
                for (int bj = 0; bj < 2; ++bj)
#pragma unroll
                    for (int n = 0; n < 2; ++n) { const size_t o = ro + bj * 128 + 4 * n; f32x4 v = *(const f32x4*)(in + o); v += acc[ai][bj][m][n]; if (real || v[0] == 1.2345e30f) *(f32x4*)(out + o) = v; } }
    }
};
struct EpiSwiglu {
    static constexpr bool PERM = true, AFTER_DRAIN = false;
    bf16_t* O;
    __device__ __forceinline__ void operator()(const f32x4 (&acc)[2][2][4][2], const pg8::Unit& u, int wr, int wc, int fr, int fq) const {
        const int row0 = u.pm * 256 + wr * 64 + fr, col0 = u.pn * 128 + wc * 32 + 8 * fq;
#pragma unroll
        for (int ai = 0; ai < 2; ++ai)
#pragma unroll
            for (int m = 0; m < 4; ++m) { bf16_t* rowp = O + (size_t)(row0 + ai * 128 + m * 16) * FF_ + col0;
                float r[8];
#pragma unroll
                for (int n = 0; n < 2; ++n)
#pragma unroll
                    for (int j = 0; j < 4; ++j) r[4 * n + j] = siluf_(acc[ai][0][m][n][j]) * acc[ai][1][m][n][j];
                u32x4 w; w.x = pk2(r[0], r[1]); w.y = pk2(r[2], r[3]); w.z = pk2(r[4], r[5]); w.w = pk2(r[6], r[7]);
                *(u32x4*)rowp = w; }
    }
};
struct EpiOddIn {
    static constexpr bool PERM = true, AFTER_DRAIN = false;
    unsigned char* big;
    __device__ __forceinline__ void operator()(const f32x4 (&acc)[2][2][4][2], const pg8::Unit& u, int wr, int wc, int fr, int fq) const {
        const int row0 = u.pm * 256 + wr * 64 + fr, pn = u.pn, ci = wc * 32 + 8 * fq;
        if (pn < 8) {
            const int head = pn & 3; const bool isk = pn >= 4;
            const float lg = __log2f(1.0f - exp2f(-5.0f - (float)head));
            bf16_t* rm = (bf16_t*)(big + (isk ? OB_KT : OB_QT));
            bf16_t* tr = (bf16_t*)(big + OB_KTT);
#pragma unroll
            for (int ai = 0; ai < 2; ++ai)
#pragma unroll
                for (int m = 0; m < 4; ++m) { const int t = row0 + ai * 128 + m * 16; const float jp = (float)((t & 255) + 1);
                    const float dec = isk ? __builtin_amdgcn_exp2f(-jp * lg) * 0.0625f : __builtin_amdgcn_exp2f(jp * lg);
                    bf16_t* rp = rm + (size_t)head * 256 * S_ + rb_off(8, t, ci);
                    bf16_t* tp = tr + (size_t)head * 256 * S_ + tb_off(256, ci, t);
#pragma unroll
                    for (int n = 0; n < 2; ++n) {
                        float y1[4], y2[4];
#pragma unroll
                        for (int j = 0; j < 4; ++j) { const float ang = (float)t * __builtin_amdgcn_exp2f(-(float)(ci + 4 * n + j) * 0.10381025296523008f);
                            const float kk = __builtin_rintf(ang * 0.15915494309189535f);
                            float rr = __builtin_fmaf(-kk, 6.28125f, ang); rr = __builtin_fmaf(-kk, 0.0019353071795864769f, rr); const float fr_ = rr * 0.15915494309189535f;
                            const float sn = __builtin_amdgcn_sinf(fr_), cs = __builtin_amdgcn_cosf(fr_);
                            const float x1 = acc[ai][0][m][n][j], x2 = acc[ai][1][m][n][j];
                            y1[j] = (x1 * cs - x2 * sn) * dec; y2[j] = (x1 * sn + x2 * cs) * dec; }
                        u32x2 w; w.x = pk2(y1[0], y1[1]); w.y = pk2(y1[2], y1[3]); *(u32x2*)(rp + 4 * n) = w;
                        w.x = pk2(y2[0], y2[1]); w.y = pk2(y2[2], y2[3]); *(u32x2*)(rp + 4 * 512 + 4 * n) = w;
                        if (isk) {
#pragma unroll
                            for (int j = 0; j < 4; ++j) { tp[(4 * n + j) * 32] = (bf16_t)f2bf(y1[j]); tp[(128 + 4 * n + j) * 32] = (bf16_t)f2bf(y2[j]); }
                        }
                        __builtin_amdgcn_sched_barrier(0);
                    } }
        } else if (pn < 16) {
            const int vh = (pn - 8) >> 1, dv0 = ((pn - 8) & 1) * 256 + ci;
            bf16_t* tr = (bf16_t*)(big + OB_VTT) + (size_t)vh * 512 * S_;
#pragma unroll
            for (int ai = 0; ai < 2; ++ai)
#pragma unroll
                for (int m = 0; m < 4; ++m) { const int t = row0 + ai * 128 + m * 16; bf16_t* tp = tr + tb_off(512, dv0, t);
#pragma unroll
                    for (int bj = 0; bj < 2; ++bj)
#pragma unroll
                        for (int e = 0; e < 8; ++e) tp[(bj * 128 + e) * 32] = (bf16_t)f2bf(acc[ai][bj][m][e >> 2][e & 3]); }
        } else {
            bf16_t* d0; bf16_t* d1; int ld; bool t1 = false; bool v0ok = true, v1ok = true;
            if (pn < 24)      { d0 = (bf16_t*)(big + OB_GC) + (pn - 16) * 256 + ci; d1 = d0 + 128; ld = 2048; }
            else if (pn < 28) { d0 = (bf16_t*)(big + OB_QD) + (pn - 24) * 256 + ci; d1 = d0 + 128; ld = 1024; }
            else if (pn == 28) { d0 = (bf16_t*)(big + OB_KCMP) + ci; d1 = (bf16_t*)(big + OB_VCMP) + ci; ld = 128; }
            else if (pn == 29) { d0 = (bf16_t*)(big + OB_KSLC); d1 = (bf16_t*)(big + OB_VSLCT); ld = 0; t1 = true; }
            else if (pn == 30) { d0 = (bf16_t*)(big + OB_KWIN); d1 = (bf16_t*)(big + OB_VWIN); ld = 0; t1 = true; }
            else               { d0 = (bf16_t*)(big + OB_GD) + ci; d1 = d0; ld = 64; v0ok = ci < 64; v1ok = false; }
#pragma unroll
            for (int ai = 0; ai < 2; ++ai)
#pragma unroll
                for (int m = 0; m < 4; ++m) { const int t = row0 + ai * 128 + m * 16;
                    if (v0ok) { const f32x4 v0 = acc[ai][0][m][0], v1 = acc[ai][0][m][1];
                        u32x4 w; w.x = pk2(v0[0], v0[1]); w.y = pk2(v0[2], v0[3]); w.z = pk2(v1[0], v1[1]); w.w = pk2(v1[2], v1[3]);
                        *(u32x4*)(t1 ? d0 + (size_t)(ci >> 6) * 64 * S_ + rb_off(2, t, ci & 63) : d0 + (size_t)t * ld) = w; }
                    if (v1ok) {
                        if (t1) {
#pragma unroll
                            for (int e = 0; e < 8; ++e) d1[(size_t)(ci >> 6) * 64 * S_ + tb_off(64, (ci & 63) + e, t)] = (bf16_t)f2bf(acc[ai][1][m][e >> 2][e & 3]);
                        } else { const f32x4 v0 = acc[ai][1][m][0], v1 = acc[ai][1][m][1];
                            u32x4 w; w.x = pk2(v0[0], v0[1]); w.y = pk2(v0[2], v0[3]); w.z = pk2(v1[0], v1[1]); w.w = pk2(v1[2], v1[3]); *(u32x4*)(d1 + (size_t)t * ld) = w; } } }
        }
    }
};

__device__ __forceinline__ void conv_tile(const float* src, int ld, int K, int col0, int ncv, bf16_t* dstrow0, int k0, LAS float* tile, int tid) {
#pragma unroll
    for (int i = 0; i < 8; ++i) { const int kk = (tid >> 6) + 8 * i, nn = tid & 63;
        tile[kk * 65 + nn] = nn < ncv ? src[(size_t)(k0 + kk) * ld + col0 + nn] : 0.f; }
    __syncthreads();
    { const int nn = tid >> 3, kc = (tid & 7) * 8; float v[8];
#pragma unroll
      for (int j = 0; j < 8; ++j) v[j] = tile[(kc + j) * 65 + nn];
      u32x4 w; w.x = pk2(v[0], v[1]); w.y = pk2(v[2], v[3]); w.z = pk2(v[4], v[5]); w.w = pk2(v[6], v[7]);
      *(u32x4*)(dstrow0 + (size_t)nn * K + k0 + kc) = w; }
    __syncthreads();
}

__device__ __forceinline__ void phase_convert(const Params& p, int layer, LAS unsigned char* lds) {
    const int tid = launder_tid(); LAS float* tile = (LAS float*)lds;
    const int li = layer >> 1; const bool odd = layer & 1;
    unsigned char* ws = launder_ptr(p.ws);
    const int n_in = odd ? 128 * 16 : 36 * 16, n_out = odd ? 16 * 48 : 16 * 16, n_gu = 88 * 16, n_dn = 16 * 44, n_c1 = odd ? 2 * 32 : 0, n_c2 = odd ? 2 : 0, n_bv = odd ? 2 : 0;
    const int o_out = n_in, o_gu = o_out + n_out, o_dn = o_gu + n_gu, o_c1k = o_dn + n_dn, o_c1v = o_c1k + n_c1, o_c2k = o_c1v + n_c1, o_c2v = o_c2k + n_c2, o_bv = o_c2v + n_c2, total = o_bv + n_bv;
    for (int u = blockIdx.x; u < total; u += gridDim.x) {
        if (u < o_out) { const int nt = u >> 4, kt = u & 15;
            if (odd) { const int Ns = 7984; const float* src = p.odd_w_in + (size_t)li * 1024 * Ns; int ncv = Ns - nt * 64; ncv = ncv > 64 ? 64 : (ncv < 0 ? 0 : ncv);
                conv_tile(src, Ns, 1024, nt * 64, ncv, (bf16_t*)(ws + WS_WIN) + (size_t)nt * 64 * 1024, kt * 64, tile, tid); }
            else { const float* src = p.even_w_in + (size_t)li * 1024 * 2304; conv_tile(src, 2304, 1024, nt * 64, 64, (bf16_t*)(ws + WS_WIN) + (size_t)nt * 64 * 1024, kt * 64, tile, tid); }
        } else if (u < o_gu) { const int v = u - o_out; const int KO = odd ? 3072 : 1024, nk = KO / 64; const int nt = v / nk, kt = v % nk;
            const float* src = odd ? p.odd_w_out + (size_t)li * 3072 * 1024 : p.even_w_out + (size_t)li * 1024 * 1024;
            conv_tile(src, 1024, KO, nt * 64, 64, (bf16_t*)(ws + WS_WOUT) + (size_t)nt * 64 * KO, kt * 64, tile, tid);
        } else if (u < o_dn) { const int v = u - o_gu; const int q = v >> 4, kt = v & 15; const int pn = q >> 2, bj = (q >> 1) & 1, i0 = 64 * (q & 1);
            const float* src = (bj ? p.ffn_w_up : p.ffn_w_gate) + (size_t)layer * 1024 * FF_;
            conv_tile(src, FF_, 1024, 128 * pn + i0, 64, (bf16_t*)(ws + WS_WGU) + (size_t)q * 64 * 1024, kt * 64, tile, tid);
        } else if (u < o_c1k) { const int v = u - o_dn; const int nt = v / 44, kt = v % 44;
            const float* src = p.ffn_w_down + (size_t)layer * FF_ * 1024;
            conv_tile(src, 1024, FF_, nt * 64, 64, (bf16_t*)(ws + WS_WDN) + (size_t)nt * 64 * FF_, kt * 64, tile, tid);
        } else if (u < o_c2k) { const bool isv = u >= o_c1v; const int v = u - (isv ? o_c1v : o_c1k); const int nt = v >> 5, kt = v & 31;
            const float* src = (isv ? p.odd_cmp_v_w1 : p.odd_cmp_k_w1) + (size_t)li * 2048 * 128;
            conv_tile(src, 128, 2048, nt * 64, 64, (bf16_t*)(ws + WS_WC1 + (isv ? 512 * 1024 : 0)) + (size_t)nt * 64 * 2048, kt * 64, tile, tid);
        } else if (u < o_bv) { const bool isv = u >= o_c2v; const int kt = u - (isv ? o_c2v : o_c2k);
            const float* src = (isv ? p.odd_cmp_v_w2 : p.odd_cmp_k_w2) + (size_t)li * 128 * 64;
            conv_tile(src, 64, 128, 0, 64, (bf16_t*)(ws + WS_WC2 + (isv ? 16384 : 0)), kt * 64, tile, tid);
        } else { const bool isv = (u - o_bv) == 1;
            const float* pos = (isv ? p.odd_cmp_pos_v : p.odd_cmp_pos_k) + (size_t)li * 2048; const float* w1 = (isv ? p.odd_cmp_v_w1 : p.odd_cmp_k_w1) + (size_t)li * 2048 * 128;
            const int hid = tid & 127, part = tid >> 7; float s = 0.f;
            for (int k = part * 512; k < part * 512 + 512; ++k) s += pos[k] * w1[(size_t)k * 128 + hid];
            tile[part * 128 + hid] = s; __syncthreads();
            if (tid < 128) ((float*)(ws + WS_SMALL))[(isv ? 128 : 0) + tid] = tile[tid] + tile[128 + tid] + tile[256 + tid] + tile[384 + tid];
            __syncthreads();
        }
    }
}

__device__ __forceinline__ void phase_rmsnorm(const float* src, const float* w, bf16_t* dstb, float* dstf, int row0 = 0, int row1 = M_) {
    const int tid_ = launder_tid(); const int lane = tid_ & 63, wave = tid_ >> 6;
    f32x4 wv[4];
#pragma unroll
    for (int i = 0; i < 4; ++i) wv[i] = *(const f32x4*)(w + 256 * i + 4 * lane);
    for (int row = row0 + blockIdx.x * 8 + wave; row < row1; row += gridDim.x * 8) {
        const float* rp = src + (size_t)row * DM; f32x4 v[4]; float ss = 0.f;
#pragma unroll
        for (int i = 0; i < 4; ++i) { v[i] = *(const f32x4*)(rp + 256 * i + 4 * lane); ss += v[i][0] * v[i][0] + v[i][1] * v[i][1] + v[i][2] * v[i][2] + v[i][3] * v[i][3]; }
#pragma unroll
        for (int o = 32; o >= 1; o >>= 1) ss += shx(ss, o, lane);
        const float rs = rsqrtf(ss * (1.0f / 1024.0f) + 1e-6f);
#pragma unroll
        for (int i = 0; i < 4; ++i) { const f32x4 y = v[i] * rs * wv[i];
            if (dstb) { u32x2 o2; o2.x = pk2(y[0], y[1]); o2.y = pk2(y[2], y[3]); *(u32x2*)(dstb + (size_t)row * DM + 256 * i + 4 * lane) = o2; }
            else *(f32x4*)(dstf + (size_t)row * DM + 256 * i + 4 * lane) = y; }
    }
}


template <bool VT>
__device__ __forceinline__ void band_unit(const bf16_t* Q, int ldq, const bf16_t* K, int ldk, const bf16_t* V, int ldv,
                                          int L, int dil, int res, int maxd, int head, int i0,
                                          bf16_t* O, int ldo, float* lse, int ldl, const bf16_t* gate, int ldg,
                                          bool has_sink, float sink, const LAS float* tbl, int lane) {
    const int g = lane >> 4, c = lane & 15;
    const int iq = i0 + c; const int tq = res + dil * iq;
    const bf16_t* qp = Q + (size_t)tq * ldq + 8 * g;
    const bf16x8 qf0 = *(const bf16x8*)qp, qf1 = *(const bf16x8*)(qp + 32);
    float m = has_sink ? sink : -1e30f, l = (has_sink && g == 0) ? 1.0f : 0.0f;
    f32x4 acc[4];
#pragma unroll
    for (int d = 0; d < 4; ++d) acc[d] = (f32x4){0.f, 0.f, 0.f, 0.f};
    int lo = i0 - maxd; lo = lo < 0 ? 0 : lo;
    const int tlo = (lo >> 4) & ~1, thi = i0 >> 4;
    bf16x8 ck[4];
    { const int tbv0 = tlo + 1 > thi ? tlo : tlo + 1;
      const bf16_t* kpa = K + (size_t)(res + dil * (16 * tlo + c)) * ldk + 8 * g; const bf16_t* kpb = K + (size_t)(res + dil * (16 * tbv0 + c)) * ldk + 8 * g;
      ck[0] = *(const bf16x8*)kpa; ck[1] = *(const bf16x8*)(kpa + 32); ck[2] = *(const bf16x8*)kpb; ck[3] = *(const bf16x8*)(kpb + 32); }
    for (int ta = tlo; ta <= thi; ta += 2) {
        const int tb = ta + 1, tbv = tb > thi ? ta : tb;
        bf16x8 nk[4];
        { const int tna = ta + 2 <= thi ? ta + 2 : ta, tnb = tna + 1 > thi ? tna : tna + 1;
          const bf16_t* kpa = K + (size_t)(res + dil * (16 * tna + c)) * ldk + 8 * g; const bf16_t* kpb = K + (size_t)(res + dil * (16 * tnb + c)) * ldk + 8 * g;
          nk[0] = *(const bf16x8*)kpa; nk[1] = *(const bf16x8*)(kpa + 32); nk[2] = *(const bf16x8*)kpb; nk[3] = *(const bf16x8*)(kpb + 32); }
        bf16x8 vfr[4];
#pragma unroll
        for (int d = 0; d < 4; ++d) {
            if (VT) { const bf16_t* vp = V + (size_t)(16 * d + c) * ldv + 4 * g; vfr[d] = mk8(*(const u32x2*)(vp + 16 * ta), *(const u32x2*)(vp + 16 * tbv)); }
            else {
#pragma unroll
                for (int j = 0; j < 4; ++j) { vfr[d][j] = (short)V[(size_t)(res + dil * (16 * ta + 4 * g + j)) * ldv + 16 * d + c]; vfr[d][4 + j] = (short)V[(size_t)(res + dil * (16 * tbv + 4 * g + j)) * ldv + 16 * d + c]; }
            }
        }
        __builtin_amdgcn_sched_barrier(0);
        f32x4 sa = mfma16(ck[0], qf0, (f32x4){0.f, 0.f, 0.f, 0.f}); sa = mfma16(ck[1], qf1, sa);
        f32x4 sb = mfma16(ck[2], qf0, (f32x4){0.f, 0.f, 0.f, 0.f}); sb = mfma16(ck[3], qf1, sb);
        float s[8]; bool ok[8];
#pragma unroll
        for (int r = 0; r < 4; ++r) {
            const int da = iq - (16 * ta + 4 * g + r), db = iq - (16 * tb + 4 * g + r);
            ok[r] = da >= 0 && da <= maxd; ok[4 + r] = db >= 0 && db <= maxd;
            s[r] = ok[r] ? sa[r] * 0.125f + tbl[t5b(da * dil) * 16 + head] : -1e30f;
            s[4 + r] = ok[4 + r] ? sb[r] * 0.125f + tbl[t5b((db < 0 ? 0 : db) * dil) * 16 + head] : -1e30f;
        }
        float mx = fmaxf(fmaxf(fmaxf(s[0], s[1]), fmaxf(s[2], s[3])), fmaxf(fmaxf(s[4], s[5]), fmaxf(s[6], s[7])));
        mx = fmaxf(mx, shx(mx, 16, lane)); mx = fmaxf(mx, shx(mx, 32, lane));
        if (__builtin_amdgcn_ballot_w64(mx > m) != 0ull) {
            const float mn = fmaxf(m, mx), alpha = __expf(m - mn); m = mn; l *= alpha;
#pragma unroll
            for (int d = 0; d < 4; ++d) acc[d] *= alpha; }
        float pr[8], ps = 0.f;
#pragma unroll
        for (int r = 0; r < 8; ++r) { pr[r] = ok[r] ? __expf(s[r] - m) : 0.f; ps += pr[r]; }
        l += ps;
        const bf16x8 pf = mk8p(pr[0], pr[1], pr[2], pr[3], pr[4], pr[5], pr[6], pr[7]);
#pragma unroll
        for (int d = 0; d < 4; ++d) {
            acc[d] = mfma16(vfr[d], pf, acc[d]);
        }
#pragma unroll
        for (int i = 0; i < 4; ++i) ck[i] = nk[i];
    }
    l += shx(l, 16, lane); l += shx(l, 32, lane);
    float inv = 1.0f / l;
    if (lse && g == 0) lse[(size_t)tq * ldl] = m + __logf(l);
    if (gate) inv *= sigmoidf_(bf2f(gate[(size_t)tq * ldg]));
#pragma unroll
    for (int d = 0; d < 4; ++d) { u32x2 w; w.x = pk2(acc[d][0] * inv, acc[d][1] * inv); w.y = pk2(acc[d][2] * inv, acc[d][3] * inv);
        *(u32x2*)(O + (size_t)tq * ldo + 16 * d + 4 * g) = w; }
}

__device__ __forceinline__ void win_unit(const unsigned char* big, bf16_t* ob, int h, int i0, const LAS float* tbl, int lane) {
    const int g = lane >> 4, c = lane & 15, grp = h >> 3, t = i0 + c;
    const bf16_t* qp = (const bf16_t*)(big + OB_QD) + (size_t)t * 1024 + h * 64 + 8 * g;
    const bf16x8 qf0 = *(const bf16x8*)qp, qf1 = *(const bf16x8*)(qp + 32);
    const bf16_t* Kb = (const bf16_t*)(big + OB_KWIN) + (size_t)grp * 64 * S_ + c * 32 + 8 * g;
    const bf16_t* Vb = (const bf16_t*)(big + OB_VWIN) + (size_t)grp * 64 * S_ + c * 32 + 8 * g;
    float m = -1e30f, l = 0.f;
    f32x4 acc[4];
#pragma unroll
    for (int d = 0; d < 4; ++d) acc[d] = (f32x4){0.f, 0.f, 0.f, 0.f};
    int lo = i0 - 511; lo = lo < 0 ? 0 : lo;
    const int tlo = (lo >> 4) & ~1, thi = i0 >> 4;
    bf16x8 ka[4], kb[4];
    auto loadk = [&](bf16x8 (&K_)[4], int tt) __attribute__((always_inline)) { const bf16_t* kp = Kb + (size_t)tt * 1024;
        K_[0] = *(const bf16x8*)kp; K_[1] = *(const bf16x8*)(kp + 512); K_[2] = *(const bf16x8*)(kp + 1024); K_[3] = *(const bf16x8*)(kp + 1536); };
    auto step = [&](const bf16x8 (&ck)[4], int ta) __attribute__((always_inline)) {
        bf16x8 cv[4];
        { const bf16_t* vp = Vb + (size_t)ta * 1024;
#pragma unroll
          for (int d = 0; d < 4; ++d) cv[d] = *(const bf16x8*)(vp + 512 * d); }
        __builtin_amdgcn_sched_barrier(0);
        f32x4 sa = mfma16(ck[0], qf0, (f32x4){0.f, 0.f, 0.f, 0.f}); sa = mfma16(ck[1], qf1, sa);
        f32x4 sb = mfma16(ck[2], qf0, (f32x4){0.f, 0.f, 0.f, 0.f}); sb = mfma16(ck[3], qf1, sb);
        float s[8]; bool ok[8];
#pragma unroll
        for (int r = 0; r < 4; ++r) {
            const int da = t - (16 * ta + 4 * g + r), db = da - 16;
            ok[r] = da >= 0 && da <= 511; ok[4 + r] = db >= 0 && db <= 511;
            s[r] = ok[r] ? sa[r] * 0.125f + tbl[t5b(da < 0 ? 0 : da) * 16 + h] : -1e30f;
            s[4 + r] = ok[4 + r] ? sb[r] * 0.125f + tbl[t5b(db < 0 ? 0 : db) * 16 + h] : -1e30f;
        }
        float mx = fmaxf(fmaxf(fmaxf(s[0], s[1]), fmaxf(s[2], s[3])), fmaxf(fmaxf(s[4], s[5]), fmaxf(s[6], s[7])));
        mx = fmaxf(mx, shx(mx, 16, lane)); mx = fmaxf(mx, shx(mx, 32, lane));
        if (__builtin_amdgcn_ballot_w64(mx > m) != 0ull) {
            const float mn = fmaxf(m, mx), alpha = __expf(m - mn); m = mn; l *= alpha;
#pragma unroll
            for (int d = 0; d < 4; ++d) acc[d] *= alpha; }
        float pr[8], ps = 0.f;
#pragma unroll
        for (int r = 0; r < 8; ++r) { pr[r] = ok[r] ? __expf(s[r] - m) : 0.f; ps += pr[r]; }
        l += ps;
        const bf16x8 pf = mk8p(pr[0], pr[1], pr[2], pr[3], pr[4], pr[5], pr[6], pr[7]);
#pragma unroll
        for (int d = 0; d < 4; ++d) acc[d] = mfma16(cv[d], pf, acc[d]);
    };
    loadk(ka, tlo);
    for (int ta = tlo; ta <= thi; ta += 4) {
        loadk(kb, ta + 2 <= thi ? ta + 2 : ta);
        step(ka, ta);
        if (ta + 2 <= thi) { loadk(ka, ta + 4 <= thi ? ta + 4 : ta + 2); step(kb, ta + 2); }
    }
    l += shx(l, 16, lane); l += shx(l, 32, lane);
    const float inv = sigmoidf_(bf2f(((const bf16_t*)(big + OB_GD))[(size_t)t * 64 + h * 3 + 2])) / l;
#pragma unroll
    for (int d = 0; d < 4; ++d) { u32x2 w; w.x = pk2(acc[d][0] * inv, acc[d][1] * inv); w.y = pk2(acc[d][2] * inv, acc[d][3] * inv);
        *(u32x2*)(ob + (size_t)t * 3072 + 2048 + h * 64 + 16 * d + 4 * g) = w; }
}

#define SEL_LOADK(K_, k0_) do { const bf16_t* kp_ = Kb + (size_t)(k0_) * 64; _Pragma("unroll") for (int i_ = 0; i_ < 8; ++i_) K_[i_] = *(const bf16x8*)(kp_ + 512 * i_); } while (0)
#define SEL_STEP(K_, k0_) do { \
    bf16x8 cv[8]; { const bf16_t* vp_ = Vb + (size_t)(k0_) * 64; _Pragma("unroll") for (int i_ = 0; i_ < 8; ++i_) cv[i_] = *(const bf16x8*)(vp_ + 512 * i_); } \
    __builtin_amdgcn_sched_barrier(0); \
    f32x4 sc[4]; \
    _Pragma("unroll") for (int i = 0; i < 4; ++i) { sc[i] = mfma16(K_[2 * i], qf0, (f32x4){0.f, 0.f, 0.f, 0.f}); sc[i] = mfma16(K_[2 * i + 1], qf1, sc[i]); } \
    float s[16]; bool ok[16]; \
    const int dmin = t - (k0_) - 63; const int bk0 = __builtin_amdgcn_readfirstlane(t5b(dmin < 0 ? 0 : dmin)); \
    if (dmin >= 0 && bk0 == __builtin_amdgcn_readfirstlane(t5b(dmin + 63))) { const float bias = tbl[bk0 * 16 + head]; \
        _Pragma("unroll") for (int i = 0; i < 4; ++i) _Pragma("unroll") for (int r = 0; r < 4; ++r) { ok[4 * i + r] = true; s[4 * i + r] = sc[i][r] * 0.125f + bias; } \
    } else { \
        _Pragma("unroll") for (int i = 0; i < 4; ++i) _Pragma("unroll") for (int r = 0; r < 4; ++r) { const int dd = t - ((k0_) + 16 * i + 4 * g + r); ok[4 * i + r] = dd >= 0; \
            s[4 * i + r] = dd >= 0 ? sc[i][r] * 0.125f + tbl[t5b(dd) * 16 + head] : -1e30f; } \
    } \
    float mx = s[0]; \
    _Pragma("unroll") for (int r = 1; r < 16; ++r) mx = fmaxf(mx, s[r]); \
    mx = fmaxf(mx, shx(mx, 16, lane)); mx = fmaxf(mx, shx(mx, 32, lane)); \
    if (__builtin_amdgcn_ballot_w64(mx > m) != 0ull) { const float mn = fmaxf(m, mx), alpha = __expf(m - mn); m = mn; l *= alpha; \
        _Pragma("unroll") for (int d = 0; d < 4; ++d) acc[d] *= alpha; } \
    float pr[16], ps = 0.f; \
    _Pragma("unroll") for (int r = 0; r < 16; ++r) { pr[r] = ok[r] ? __expf(s[r] - m) : 0.f; ps += pr[r]; } \
    l += ps; \
    const bf16x8 pf0 = mk8p(pr[0], pr[1], pr[2], pr[3], pr[4], pr[5], pr[6], pr[7]), pf1 = mk8p(pr[8], pr[9], pr[10], pr[11], pr[12], pr[13], pr[14], pr[15]); \
    _Pragma("unroll") for (int d = 0; d < 4; ++d) { acc[d] = mfma16(cv[d], pf0, acc[d]); acc[d] = mfma16(cv[4 + d], pf1, acc[d]); } } while (0)
__device__ __forceinline__ void sel_unit(const unsigned char* big, const int* idx, bf16_t* ob, int t, int grp, const LAS float* tbl, int lane, bool real = true) {
    const int g = lane >> 4, c = lane & 15, head = grp * 8 + (c & 7);
    const bf16_t* qp = (const bf16_t*)(big + OB_QD) + (size_t)t * 1024 + head * 64 + 8 * g;
    const bf16x8 qf0 = *(const bf16x8*)qp, qf1 = *(const bf16x8*)(qp + 32);
    const bf16_t* Kb = (const bf16_t*)(big + OB_KSLC) + (size_t)grp * 64 * S_ + c * 32 + 8 * g;
    const bf16_t* Vb = (const bf16_t*)(big + OB_VSLCT) + (size_t)grp * 64 * S_ + c * 32 + 8 * g;
    float m = -1e30f, l = 0.f;
    f32x4 acc[4];
#pragma unroll
    for (int d = 0; d < 4; ++d) acc[d] = (f32x4){0.f, 0.f, 0.f, 0.f};
    const int* ip = idx + ((size_t)t * 2 + grp) * 16;
    int nsel = (t >> 6) + 1; nsel = nsel > 16 ? 16 : nsel;
    int k0a = __builtin_amdgcn_readfirstlane(ip[0]) * 64;
    bf16x8 ka[8], kb[8];
    SEL_LOADK(ka, k0a);
    for (int si = 0; si < nsel; si += 2) {
        const int s1 = si + 1 < nsel ? si + 1 : si;
        const int k0b = __builtin_amdgcn_readfirstlane(ip[s1]) * 64;
        SEL_LOADK(kb, k0b);
        SEL_STEP(ka, k0a);
        if (si + 1 < nsel) {
            const int s2 = si + 2 < nsel ? si + 2 : s1;
            const int k0n = __builtin_amdgcn_readfirstlane(ip[s2]) * 64;
            SEL_LOADK(ka, k0n);
            SEL_STEP(kb, k0b);
            k0a = k0n;
        }
    }
    l += shx(l, 16, lane); l += shx(l, 32, lane);
    if (c < 8 && real) {
        const float gt = sigmoidf_(bf2f(((const bf16_t*)(big + OB_GD))[(size_t)t * 64 + head * 3 + 1])) / l;
#pragma unroll
        for (int d = 0; d < 4; ++d) { bf16_t* op = ob + (size_t)t * 3072 + 2048 + head * 64 + 16 * d + 4 * g; const u32x2 o = *(const u32x2*)op;
            u32x2 w; w.x = pk2(bflo(o.x) + acc[d][0] * gt, bfhi(o.x) + acc[d][1] * gt); w.y = pk2(bflo(o.y) + acc[d][2] * gt, bfhi(o.y) + acc[d][3] * gt); *(u32x2*)op = w; }
    }
}

__device__ __forceinline__ void cmp_unit(const unsigned char* big, const unsigned char* misc, int* idx, bf16_t* ob, int t0, int grp, const LAS float* tbl, LAS float* impall, int wave, int lane, bool real = true) {
    const int g = lane >> 4, c = lane & 15, t = t0 + c, head = grp * 8 + wave;
    LAS float* imp = impall + wave * (16 * 257);
    int cnt = t0 >> 4; cnt = cnt > 1023 ? 1023 : cnt;
    const int npair = (cnt + 31) >> 5;
    const bf16_t* KC = (const bf16_t*)(misc + MS_KC) + (size_t)grp * 65536 + c * 32 + 8 * g;
    const bf16_t* VCT = (const bf16_t*)(misc + MS_VCT) + (size_t)grp * 65536 + c * 32 + 8 * g;
    if (cnt > 0) {
        const bf16_t* qp = (const bf16_t*)(big + OB_QD) + (size_t)t * 1024 + head * 64 + 8 * g;
        const bf16x8 qf0 = *(const bf16x8*)qp, qf1 = *(const bf16x8*)(qp + 32);
        float m = -1e30f, l = 0.f;
        bf16x8 ck[4];
        ck[0] = *(const bf16x8*)KC; ck[1] = *(const bf16x8*)(KC + 512); ck[2] = *(const bf16x8*)(KC + 1024); ck[3] = *(const bf16x8*)(KC + 1536);
        for (int pi = 0; pi < npair; ++pi) {
            const int pn = pi + 1 < npair ? pi + 1 : pi; const bf16_t* kp = KC + (size_t)pn * 2048;
            bf16x8 nk[4]; nk[0] = *(const bf16x8*)kp; nk[1] = *(const bf16x8*)(kp + 512); nk[2] = *(const bf16x8*)(kp + 1024); nk[3] = *(const bf16x8*)(kp + 1536);
            __builtin_amdgcn_sched_barrier(0);
            f32x4 sa = mfma16(ck[0], qf0, (f32x4){0.f, 0.f, 0.f, 0.f}); sa = mfma16(ck[1], qf1, sa);
            f32x4 sb = mfma16(ck[2], qf0, (f32x4){0.f, 0.f, 0.f, 0.f}); sb = mfma16(ck[3], qf1, sb);
            float s[8]; bool ok[8];
            const int dmin = t0 - (16 * (32 * pi + 31) + 31); const int bk0 = __builtin_amdgcn_readfirstlane(t5b(dmin < 0 ? 0 : dmin));
            if (dmin >= 0 && pi < 31 && bk0 == __builtin_amdgcn_readfirstlane(t5b(dmin + 511))) {
                const float bias = tbl[bk0 * 16 + head];
#pragma unroll
                for (int r = 0; r < 4; ++r) { ok[r] = true; ok[4 + r] = true; s[r] = sa[r] * 0.125f + bias; s[4 + r] = sb[r] * 0.125f + bias; }
            } else {
#pragma unroll
                for (int r = 0; r < 4; ++r) {
                    const int na = 32 * pi + 4 * g + r, nb = na + 16; const int da = t - (16 * na + 31), db = da - 256;
                    ok[r] = da >= 0 && na < 1023; ok[4 + r] = db >= 0 && nb < 1023;
                    s[r] = ok[r] ? sa[r] * 0.125f + tbl[t5b(da) * 16 + head] : -1e30f;
                    s[4 + r] = ok[4 + r] ? sb[r] * 0.125f + tbl[t5b(db < 0 ? 0 : db) * 16 + head] : -1e30f;
                }
            }
            float mx = fmaxf(fmaxf(fmaxf(s[0], s[1]), fmaxf(s[2], s[3])), fmaxf(fmaxf(s[4], s[5]), fmaxf(s[6], s[7])));
            const float mn = fmaxf(m, mx); float ps = 0.f;
#pragma unroll
            for (int r = 0; r < 8; ++r) ps += ok[r] ? __expf(s[r] - mn) : 0.f;
            l = l * __expf(m - mn) + ps; m = mn;
#pragma unroll
            for (int i = 0; i < 4; ++i) ck[i] = nk[i];
        }
        {
            float mo = shx(m, 16, lane), lo = shx(l, 16, lane); float mn = fmaxf(m, mo); l = l * __expf(m - mn) + lo * __expf(mo - mn); m = mn;
            mo = shx(m, 32, lane); lo = shx(l, 32, lane); mn = fmaxf(m, mo); l = l * __expf(m - mn) + lo * __expf(mo - mn); m = mn;
        }
        const float il = l > 0.f ? 1.0f / l : 0.f;
        f32x4 acc[4];
#pragma unroll
        for (int d = 0; d < 4; ++d) acc[d] = (f32x4){0.f, 0.f, 0.f, 0.f};
        bf16x8 cv[4];
        ck[0] = *(const bf16x8*)KC; ck[1] = *(const bf16x8*)(KC + 512); ck[2] = *(const bf16x8*)(KC + 1024); ck[3] = *(const bf16x8*)(KC + 1536);
        float carry = 0.f;
        for (int pi = 0; pi < npair; ++pi) {
            const int pn = pi + 1 < npair ? pi + 1 : pi; const bf16_t* kp = KC + (size_t)pn * 2048;
            bf16x8 nk[4]; nk[0] = *(const bf16x8*)kp; nk[1] = *(const bf16x8*)(kp + 512); nk[2] = *(const bf16x8*)(kp + 1024); nk[3] = *(const bf16x8*)(kp + 1536);
#pragma unroll
            for (int d = 0; d < 4; ++d) cv[d] = *(const bf16x8*)(VCT + (size_t)pi * 2048 + 512 * d);
            __builtin_amdgcn_sched_barrier(0);
            f32x4 sa = mfma16(ck[0], qf0, (f32x4){0.f, 0.f, 0.f, 0.f}); sa = mfma16(ck[1], qf1, sa);
            f32x4 sb = mfma16(ck[2], qf0, (f32x4){0.f, 0.f, 0.f, 0.f}); sb = mfma16(ck[3], qf1, sb);
            float pr[8];
            const int dmin = t0 - (16 * (32 * pi + 31) + 31); const int bk0 = __builtin_amdgcn_readfirstlane(t5b(dmin < 0 ? 0 : dmin));
            if (dmin >= 0 && pi < 31 && bk0 == __builtin_amdgcn_readfirstlane(t5b(dmin + 511))) {
                const float bm = tbl[bk0 * 16 + head] - m;
#pragma unroll
                for (int r = 0; r < 4; ++r) { pr[r] = __expf(sa[r] * 0.125f + bm) * il; pr[4 + r] = __expf(sb[r] * 0.125f + bm) * il; }
            } else {
#pragma unroll
                for (int r = 0; r < 4; ++r) {
                    const int na = 32 * pi + 4 * g + r, nb = na + 16; const int da = t - (16 * na + 31), db = da - 256;
                    const bool oka = da >= 0 && na < 1023, okb = db >= 0 && nb < 1023;
                    pr[r] = oka ? __expf(sa[r] * 0.125f + tbl[t5b(da) * 16 + head] - m) * il : 0.f;
                    pr[4 + r] = okb ? __expf(sb[r] * 0.125f + tbl[t5b(db < 0 ? 0 : db) * 16 + head] - m) * il : 0.f;
                }
            }
            const bf16x8 pf = mk8p(pr[0], pr[1], pr[2], pr[3], pr[4], pr[5], pr[6], pr[7]);
#pragma unroll
            for (int d = 0; d < 4; ++d) acc[d] = mfma16(cv[d], pf, acc[d]);
            const float ra = __builtin_bit_cast(float, __builtin_amdgcn_ds_bpermute(((lane - 16) & 63) << 2, __builtin_bit_cast(int, pr[3])));
            const float rb = __builtin_bit_cast(float, __builtin_amdgcn_ds_bpermute(((lane - 16) & 63) << 2, __builtin_bit_cast(int, pr[7])));
            LAS float* ir = imp + c * 257 + 8 * pi + g;
            ir[0] = ((pr[0] + pr[1]) + (pr[2] + pr[3])) + (g > 0 ? ra : carry);
            ir[4] = ((pr[4] + pr[5]) + (pr[6] + pr[7])) + (g > 0 ? rb : ra);
            carry = rb;
#pragma unroll
            for (int i = 0; i < 4; ++i) ck[i] = nk[i];
        }
        if (real) {
            const float gt = sigmoidf_(bf2f(((const bf16_t*)(big + OB_GD))[(size_t)t * 64 + head * 3 + 0]));
#pragma unroll
            for (int d = 0; d < 4; ++d) { bf16_t* op = ob + (size_t)t * 3072 + 2048 + head * 64 + 16 * d + 4 * g; const u32x2 o = *(const u32x2*)op;
                u32x2 w; w.x = pk2(bflo(o.x) + acc[d][0] * gt, bfhi(o.x) + acc[d][1] * gt); w.y = pk2(bflo(o.y) + acc[d][2] * gt, bfhi(o.y) + acc[d][3] * gt); *(u32x2*)op = w; }
        }
    }
    __syncthreads();
    for (int qq = 0; qq < 2; ++qq) {
        const int qi = 2 * wave + qq, tq = t0 + qi, cur = tq >> 6; int* ip = idx + ((size_t)tq * 2 + grp) * 16;
        if (cur <= 15) { if (lane < 16 && real) ip[lane] = lane <= cur ? lane : -1; continue; }
        float v[4];
#pragma unroll
        for (int i = 0; i < 4; ++i) { const int j = lane + 64 * i; float a = 0.f;
#pragma unroll
            for (int w = 0; w < 8; ++w) a += impall[w * (16 * 257) + qi * 257 + j];
            v[i] = (j >= 1 && j <= cur - 2) ? a : -1.f; }
        if (lane == 0 && real) { ip[0] = 0; ip[1] = cur - 1; ip[2] = cur; }
        for (int rnd = 0; rnd < 13; ++rnd) {
            float bv = v[0]; int bj = lane;
#pragma unroll
            for (int i = 1; i < 4; ++i) if (v[i] > bv) { bv = v[i]; bj = lane + 64 * i; }
            float wm = bv;
            wm = fmaxf(wm, __builtin_bit_cast(float, __builtin_amdgcn_update_dpp(0, __builtin_bit_cast(int, wm), 0xB1, 0xF, 0xF, false)));
            wm = fmaxf(wm, __builtin_bit_cast(float, __builtin_amdgcn_update_dpp(0, __builtin_bit_cast(int, wm), 0x4E, 0xF, 0xF, false)));
            wm = fmaxf(wm, __builtin_bit_cast(float, __builtin_amdgcn_update_dpp(0, __builtin_bit_cast(int, wm), 0x124, 0xF, 0xF, false)));
            wm = fmaxf(wm, __builtin_bit_cast(float, __builtin_amdgcn_update_dpp(0, __builtin_bit_cast(int, wm), 0x128, 0xF, 0xF, false)));
            const float r0 = __builtin_bit_cast(float, __builtin_amdgcn_readlane(__builtin_bit_cast(int, wm), 0)), r1 = __builtin_bit_cast(float, __builtin_amdgcn_readlane(__builtin_bit_cast(int, wm), 16));
            const float r2 = __builtin_bit_cast(float, __builtin_amdgcn_readlane(__builtin_bit_cast(int, wm), 32)), r3 = __builtin_bit_cast(float, __builtin_amdgcn_readlane(__builtin_bit_cast(int, wm), 48));
            const float gm = fmaxf(fmaxf(r0, r1), fmaxf(r2, r3));
            const unsigned long long bal = __ballot(bv == gm);
            const int owner = __builtin_ctzll(bal);
            const int pick = __builtin_amdgcn_readlane(bj, owner);
#pragma unroll
            for (int i = 0; i < 4; ++i) if (pick == lane + 64 * i) v[i] = -2.f;
            if (lane == 0 && real) ip[3 + rnd] = pick;
        }
    }
    __syncthreads();
}

__device__ __forceinline__ void compress_unit(const unsigned char* ws, const unsigned char* big, unsigned char* misc, int n0, int grp, int kind, int lane) {
    const int g = lane >> 4, c = lane & 15;
    const bf16_t* src = (const bf16_t*)(big + (kind ? OB_VCMP : OB_KCMP)) + grp * 64;
    const bf16_t* w1 = (const bf16_t*)(ws + WS_WC1 + (kind ? 512 * 1024 : 0));
    const bf16_t* w2 = (const bf16_t*)(ws + WS_WC2 + (kind ? 16384 : 0));
    const float* bv = (const float*)(ws + WS_SMALL) + (kind ? 128 : 0);
    const int n = n0 + c; int rbase = 16 * n; rbase = rbase > S_ - 32 ? S_ - 32 : rbase;
    f32x4 hacc[8];
#pragma unroll
    for (int h = 0; h < 8; ++h) hacc[h] = (f32x4){0.f, 0.f, 0.f, 0.f};
#pragma unroll 4
    for (int ks = 0; ks < 64; ++ks) {
        const bf16x8 xf = *(const bf16x8*)(src + (size_t)(rbase + (ks >> 1)) * 128 + 32 * (ks & 1) + 8 * g);
#pragma unroll
        for (int h = 0; h < 8; ++h) hacc[h] = mfma16(*(const bf16x8*)(w1 + (size_t)(16 * h + c) * 2048 + 32 * ks + 8 * g), xf, hacc[h]);
    }
#pragma unroll
    for (int h = 0; h < 8; ++h) { const f32x4 b4 = *(const f32x4*)(bv + 16 * h + 4 * g);
#pragma unroll
        for (int r = 0; r < 4; ++r) { const float x = hacc[h][r] + b4[r]; const float u = 0.7978845608028654f * (x + 0.044715f * x * x * x);
            const float th = 1.0f - 2.0f / (1.0f + __expf(2.0f * u)); hacc[h][r] = 0.5f * x * (1.0f + th); } }
    f32x4 oacc[4];
#pragma unroll
    for (int d = 0; d < 4; ++d) oacc[d] = (f32x4){0.f, 0.f, 0.f, 0.f};
#pragma unroll
    for (int s = 0; s < 4; ++s) {
        const bf16x8 hf = mk8p(hacc[2 * s][0], hacc[2 * s][1], hacc[2 * s][2], hacc[2 * s][3], hacc[2 * s + 1][0], hacc[2 * s + 1][1], hacc[2 * s + 1][2], hacc[2 * s + 1][3]);
#pragma unroll
        for (int d = 0; d < 4; ++d) { const bf16_t* wp = w2 + (size_t)(16 * d + c) * 128 + 32 * s + 4 * g;
            oacc[d] = mfma16(mk8(*(const u32x2*)wp, *(const u32x2*)(wp + 16)), hf, oacc[d]); }
    }
    if (kind == 0) { bf16_t* kc = (bf16_t*)(misc + MS_KC) + (size_t)grp * 65536;
#pragma unroll
        for (int d = 0; d < 4; ++d) { u32x2 w; w.x = pk2(oacc[d][0], oacc[d][1]); w.y = pk2(oacc[d][2], oacc[d][3]); *(u32x2*)(kc + rb_off(2, n, 16 * d + 4 * g)) = w; }
    } else { bf16_t* vct = (bf16_t*)(misc + MS_VCT) + (size_t)grp * 65536;
#pragma unroll
        for (int d = 0; d < 4; ++d)
#pragma unroll
            for (int r = 0; r < 4; ++r) vct[tb_off(64, 16 * d + 4 * g + r, n)] = (bf16_t)f2bf(oacc[d][r]);
    }
}

__device__ __forceinline__ void u_unit(const unsigned char* big, bf16_t* UT, int hh, int ch, int dvt, int lane) {
    const int g = lane >> 4, c = lane & 15;
    const bf16_t* KTT = (const bf16_t*)(big + OB_KTT) + (size_t)hh * 256 * S_ + ((size_t)(ch * 8) * 256 + c) * 32 + 8 * g;
    const bf16_t* VTT = (const bf16_t*)(big + OB_VTT) + (size_t)hh * 512 * S_ + ((size_t)(ch * 8) * 512 + 16 * dvt + c) * 32 + 8 * g;
    f32x4 acc[2][16];
#pragma unroll
    for (int i = 0; i < 16; ++i) { acc[0][i] = (f32x4){0.f, 0.f, 0.f, 0.f}; acc[1][i] = (f32x4){0.f, 0.f, 0.f, 0.f}; }
    for (int ks = 0; ks < 8; ++ks) {
        const bf16x8 vf0 = *(const bf16x8*)(VTT + (size_t)ks * 512 * 32), vf1 = *(const bf16x8*)(VTT + (size_t)ks * 512 * 32 + 8 * 16 * 32);
#pragma unroll
        for (int i = 0; i < 16; ++i) { const bf16x8 kf = *(const bf16x8*)(KTT + (size_t)ks * 256 * 32 + 512 * i); acc[0][i] = mfma16(kf, vf0, acc[0][i]); acc[1][i] = mfma16(kf, vf1, acc[1][i]); }
    }
#pragma unroll
    for (int h2 = 0; h2 < 2; ++h2) {
        bf16_t* up = UT + (size_t)(hh * 64 + ch) * 131072 + ((size_t)((dvt + 8 * h2) * 8) * 16 + c) * 32 + 4 * g;
#pragma unroll
        for (int i = 0; i < 16; ++i) { u32x2 w; w.x = pk2(acc[h2][i][0], acc[h2][i][1]); w.y = pk2(acc[h2][i][2], acc[h2][i][3]); *(u32x2*)(up + (i >> 1) * 512 + 16 * (i & 1)) = w; }
    }
}
__device__ __forceinline__ void scan_items(bf16_t* UT, int gw, int nw, int lane) {
    for (int item = gw * 64 + lane; item < 4 * 32768; item += nw * 64) {
        const int hh = item >> 15, e4 = item & 32767;
        const float dec = exp2f(256.0f * __log2f(1.0f - exp2f(-5.0f - (float)hh)));
        bf16_t* pp = UT + (size_t)hh * 64 * 131072 + (size_t)e4 * 4;
        float r0 = 0.f, r1 = 0.f, r2 = 0.f, r3 = 0.f;
#pragma unroll 8
        for (int ch = 0; ch < 64; ++ch) { u32x2* q = (u32x2*)(pp + (size_t)ch * 131072); const u32x2 u = *q;
            u32x2 w; w.x = pk2(r0, r1); w.y = pk2(r2, r3); *q = w;
            r0 = dec * (r0 + bflo(u.x)); r1 = dec * (r1 + bfhi(u.x)); r2 = dec * (r2 + bflo(u.y)); r3 = dec * (r3 + bfhi(u.y)); }
    }
}

__device__ __forceinline__ void intra_unit(const unsigned char* big, const bf16_t* UT, bf16_t* ob, const float* gn, int hh, int t0, int lane, bool real = true) {
    const int g = lane >> 4, c = lane & 15, t = t0 + c;
    const bf16_t* qp = (const bf16_t*)(big + OB_QT) + (size_t)hh * 256 * S_ + ((size_t)(t0 >> 4) * 8 * 16 + c) * 32 + 8 * g;
    const bf16_t* KT = (const bf16_t*)(big + OB_KT) + (size_t)hh * 256 * S_ + c * 32 + 8 * g;
    const bf16_t* VTTb = (const bf16_t*)(big + OB_VTT) + (size_t)hh * 512 * S_ + c * 32 + 8 * g;
    bf16_t* orow = ob + (size_t)t * 3072 + hh * 512 + 4 * g;
    const int tlo = (t0 & ~255) >> 4, thi = t0 >> 4;
    const bf16_t* RTb = UT + (size_t)(hh * 64 + (t0 >> 8)) * 131072 + c * 32 + 8 * g;
    float sum = 0.f, sq = 0.f;
    bf16x8 pfs[8];
    const int np = ((thi - tlo) >> 1) + 1;
#pragma unroll
    for (int pi = 0; pi < 8; ++pi) {
        if (pi < np) {
            const int ta = tlo + 2 * pi, tb = ta + 1;
            const bf16_t* kpa = KT + (size_t)ta * 4096; const bf16_t* kpb = kpa + 4096;
            f32x4 sa = (f32x4){0.f, 0.f, 0.f, 0.f}, sb = (f32x4){0.f, 0.f, 0.f, 0.f};
#pragma unroll
            for (int s = 0; s < 8; ++s) { const bf16x8 qf = *(const bf16x8*)(qp + 512 * s); sa = mfma16(*(const bf16x8*)(kpa + 512 * s), qf, sa); sb = mfma16(*(const bf16x8*)(kpb + 512 * s), qf, sb);
                if ((s & 3) == 3) __builtin_amdgcn_sched_barrier(0); }
            float pr[8];
#pragma unroll
            for (int r = 0; r < 4; ++r) { pr[r] = (16 * ta + 4 * g + r <= t) ? sa[r] : 0.f; pr[4 + r] = (16 * tb + 4 * g + r <= t) ? sb[r] : 0.f; }
            pfs[pi] = mk8p(pr[0], pr[1], pr[2], pr[3], pr[4], pr[5], pr[6], pr[7]);
        } else pfs[pi] = (bf16x8){0, 0, 0, 0, 0, 0, 0, 0};
    }
#pragma nounroll
    for (int hf = 0; hf < 4; ++hf) {
        f32x4 acc[8];
#pragma unroll
        for (int d = 0; d < 8; ++d) acc[d] = (f32x4){0.f, 0.f, 0.f, 0.f};
#pragma unroll
        for (int dh = 0; dh < 2; ++dh) {
            const bf16_t* vp0 = VTTb + ((size_t)(tlo >> 1) * 512 + 16 * (hf * 8 + dh * 4)) * 32;
            bf16x8 cv[4];
#pragma unroll
            for (int d = 0; d < 4; ++d) cv[d] = *(const bf16x8*)(vp0 + 512 * d);
#pragma unroll
            for (int pi = 0; pi < 8; ++pi) {
                if (pi < np) {
                    bf16x8 nv[4];
                    const bf16_t* vp = vp0 + (size_t)(pi + 1 < np ? pi + 1 : pi) * 512 * 32;
#pragma unroll
                    for (int d = 0; d < 4; ++d) nv[d] = *(const bf16x8*)(vp + 512 * d);
                    __builtin_amdgcn_sched_barrier(0);
#pragma unroll
                    for (int d = 0; d < 4; ++d) acc[dh * 4 + d] = mfma16(cv[d], pfs[pi], acc[dh * 4 + d]);
#pragma unroll
                    for (int d = 0; d < 4; ++d) cv[d] = nv[d];
                }
            }
        }
#pragma unroll
        for (int dh = 0; dh < 2; ++dh) {
            const bf16_t* rp0 = RTb + (size_t)(hf * 8 + dh * 4) * 8 * 512;
            bf16x8 cr[4];
#pragma unroll
            for (int d = 0; d < 4; ++d) cr[d] = *(const bf16x8*)(rp0 + (size_t)d * 8 * 512);
#pragma unroll
            for (int ks = 0; ks < 8; ++ks) {
                bf16x8 nr[4]; const int kn = ks < 7 ? ks + 1 : ks;
                const bf16x8 cq = *(const bf16x8*)(qp + 512 * ks);
#pragma unroll
                for (int d = 0; d < 4; ++d) nr[d] = *(const bf16x8*)(rp0 + (size_t)(d * 8 + kn) * 512);
                __builtin_amdgcn_sched_barrier(0);
#pragma unroll
                for (int d = 0; d < 4; ++d) acc[dh * 4 + d] = mfma16(cr[d], cq, acc[dh * 4 + d]);
#pragma unroll
                for (int d = 0; d < 4; ++d) cr[d] = nr[d];
            }
        }
#pragma unroll
        for (int d = 0; d < 8; ++d) {
            const float x0 = acc[d][0], x1 = acc[d][1], x2 = acc[d][2], x3 = acc[d][3];
            sum += (x0 + x1) + (x2 + x3); sq += (x0 * x0 + x1 * x1) + (x2 * x2 + x3 * x3);
            u32x2 w; w.x = pk2(x0, x1); w.y = pk2(x2, x3); if (real) *(u32x2*)(orow + 16 * (hf * 8 + d)) = w; else sq += bflo(w.x) + bflo(w.y); }
        __builtin_amdgcn_sched_barrier(0);
    }
    sum += shx(sum, 16, lane); sum += shx(sum, 32, lane); sq += shx(sq, 16, lane); sq += shx(sq, 32, lane);
    const float mu = sum * (1.0f / 512.0f); float var = sq * (1.0f / 512.0f) - mu * mu; var = var < 0.f ? 0.f : var;
    const float rs = rsqrtf(var + 1e-5f);
    const bf16_t* gcp = (const bf16_t*)(big + OB_GC) + (size_t)t * 2048 + hh * 512 + 4 * g;
    const float* gnp = gn + hh * 512 + 4 * g;
#pragma unroll
    for (int d = 0; d < 32; ++d) { const u32x2 gc = *(const u32x2*)(gcp + 16 * d); const f32x4 gw = *(const f32x4*)(gnp + 16 * d); const u32x2 o = *(const u32x2*)(orow + 16 * d);
        const float y0 = (bflo(o.x) - mu) * rs * gw[0] * siluf_(bflo(gc.x)), y1 = (bfhi(o.x) - mu) * rs * gw[1] * siluf_(bfhi(gc.x));
        const float y2 = (bflo(o.y) - mu) * rs * gw[2] * siluf_(bflo(gc.y)), y3 = (bfhi(o.y) - mu) * rs * gw[3] * siluf_(bfhi(gc.y));
        u32x2 w; w.x = pk2(y0, y1); w.y = pk2(y2, y3); if (real || y0 == 1.2345f) *(u32x2*)(orow + 16 * d) = w;
        if ((d & 3) == 3) __builtin_amdgcn_sched_barrier(0); }
}

#ifndef REP_CHAIN
#define REP_CHAIN 1
#define REP_WIN 1
#define REP_CMP 1
#define REP_INTRA 1
#define REP_SEL 1
#define REP_EATT 1
#define REP_GIN 1
#define REP_GGU 1
#define REP_MISC 1
#endif
#define XB_TMO      128
#define XB_XCNT(j)  (256  + 64 * (j))
#define XB_XSUB(j)  (1280 + 64 * (j))
#define XB_XGEN(j)  (2304 + 64 * (j))
#define XB_TOP      3328
#define XB_TOPGEN   3392
#define XCD_BAR_WORDS 3456
#define XB_SPIN_CAP (1u << 18)

__device__ __forceinline__ unsigned xb_ld(unsigned* p)              { return __hip_atomic_load(p, __ATOMIC_RELAXED, __HIP_MEMORY_SCOPE_AGENT); }
__device__ __forceinline__ unsigned xb_add(unsigned* p, unsigned v) { return __hip_atomic_fetch_add(p, v, __ATOMIC_RELAXED, __HIP_MEMORY_SCOPE_AGENT); }
__device__ __forceinline__ unsigned xb_xcc_id() { return (unsigned)__builtin_amdgcn_s_getreg((3 << 11) | 20) & 0xFu; }
#define XB_SPIN(cond, bar) do { unsigned _sp = 0; while (cond) { __builtin_amdgcn_s_sleep(1); \
    if ((++_sp & 255u) == 0u) { if (xb_ld(&(bar)[XB_TMO])) break; if (_sp > XB_SPIN_CAP) { atomicAdd(&(bar)[XB_TMO], 1u); break; } } } } while (0)

struct XcdBarrier {
    unsigned* bar; unsigned x;
    volatile LAS unsigned* st;
};

__device__ __forceinline__ XcdBarrier xcd_barrier_post(unsigned* bar, volatile LAS unsigned* st) {
    XcdBarrier b; b.bar = bar; b.x = xb_xcc_id(); b.st = st;
    if (threadIdx.x == 0) (void)xb_add(&bar[XB_XCNT(b.x)], 1u);
    return b;
}
__device__ __forceinline__ void xcd_barrier_complete(unsigned* bar, unsigned x, unsigned& nloc, unsigned& nx) {
    const unsigned G = gridDim.x * gridDim.y * gridDim.z;
    unsigned sum, cnt, mine, sp = 0u;
    for (;;) {
        sum = 0u; cnt = 0u; mine = 0u;
#pragma unroll
        for (unsigned j = 0; j < 16; ++j) { const unsigned c = xb_ld(&bar[XB_XCNT(j)]); sum += c; cnt += (c > 0u) ? 1u : 0u; mine = (j == x) ? c : mine; }
        if (sum == G) break;
        __builtin_amdgcn_s_sleep(1);
        if ((++sp & 255u) == 0u) { if (xb_ld(&bar[XB_TMO])) break; if (sp > XB_SPIN_CAP) { atomicAdd(&bar[XB_TMO], 1u); break; } }
    }
    nloc = mine > 0u ? mine : 1u; nx = cnt > 0u ? cnt : 1u;
}

__device__ __forceinline__ void xcd_barrier(const XcdBarrier& b) {
    asm volatile("s_waitcnt vmcnt(0)" ::: "memory");
    __syncthreads();
    if (threadIdx.x == 0) {
        unsigned* bar = b.bar;
        __builtin_amdgcn_s_waitcnt(0);
        unsigned nloc = b.st[0], nx = b.st[1];
        if (nloc == 0u) { xcd_barrier_complete(bar, b.x, nloc, nx); b.st[0] = nloc; b.st[1] = nx; }
        const unsigned old = xb_add(&bar[XB_XSUB(b.x)], 1u);
        const unsigned gen = old / nloc;
        if (old + 1u == (gen + 1u) * nloc) {
            __builtin_amdgcn_fence(__ATOMIC_RELEASE, "agent");
            asm volatile("s_waitcnt vmcnt(0)" ::: "memory");
            const unsigned og = xb_add(&bar[XB_TOP], 1u);
            const unsigned tg = og / nx;
            if (og + 1u == (tg + 1u) * nx) xb_add(&bar[XB_TOPGEN], 1u);
            else XB_SPIN(xb_ld(&bar[XB_TOPGEN]) == tg, bar);
            __builtin_amdgcn_fence(__ATOMIC_ACQUIRE, "agent");
            xb_add(&bar[XB_XGEN(b.x)], 1u);
            asm volatile("s_waitcnt vmcnt(0)" ::: "memory");
        } else {
            XB_SPIN(xb_ld(&bar[XB_XGEN(b.x)]) == gen, bar);
            __builtin_amdgcn_fence(__ATOMIC_ACQUIRE, "agent");
            asm volatile("s_waitcnt vmcnt(0)" ::: "memory");
        }
    }
    __syncthreads();
}

#ifndef REP_GRES
#define REP_GRES 1
#endif
#ifndef REP_GEIN
#define REP_GEIN 1
#endif
#ifndef REP_SYNC
#define REP_SYNC 1
#endif
#define REAL_(rep, R) ((rep) == (R) - 1 || p.ph_lo < 0)
typedef const __attribute__((address_space(4))) Params* KP;
typedef const __attribute__((address_space(4))) Params* KP;
__device__ __forceinline__ Params load_params() { KP k = (KP)__builtin_amdgcn_kernarg_segment_ptr(); asm volatile("" : "+s"(k)); Params r; r.x = k->x; r.rel_table = k->rel_table; r.norm_mix = k->norm_mix; r.norm_ffn = k->norm_ffn; r.norm_final = k->norm_final; r.even_w_in = k->even_w_in; r.even_sinks = k->even_sinks; r.even_w_out = k->even_w_out; r.odd_w_in = k->odd_w_in; r.odd_ret_gn = k->odd_ret_gn; r.odd_cmp_pos_k = k->odd_cmp_pos_k; r.odd_cmp_pos_v = k->odd_cmp_pos_v; r.odd_cmp_k_w1 = k->odd_cmp_k_w1; r.odd_cmp_k_w2 = k->odd_cmp_k_w2; r.odd_cmp_v_w1 = k->odd_cmp_v_w1; r.odd_cmp_v_w2 = k->odd_cmp_v_w2; r.odd_w_out = k->odd_w_out; r.ffn_w_gate = k->ffn_w_gate; r.ffn_w_up = k->ffn_w_up; r.ffn_w_down = k->ffn_w_down; r.out = k->out; r.ws = k->ws; r.ph_lo = k->ph_lo; r.ph_hi = k->ph_hi; return r; }
__global__ void __launch_bounds__(512, 2) trunk_fwd(Params p0) {
    extern __shared__ __attribute__((aligned(16))) unsigned char lds_raw[];
    LAS unsigned char* lds = (LAS unsigned char*)lds_raw;
    LAS float* tbl = (LAS float*)(lds + LDS_TBL);
    cg::grid_group grid = cg::this_grid();
    const int G = gridDim.x, nw = 8 * G;
    tbl[threadIdx.x] = p0.rel_table[threadIdx.x];
    volatile LAS unsigned* xst = (volatile LAS unsigned*)(lds + LDS_XB);
    if (threadIdx.x < 4) xst[threadIdx.x] = 0u;
    __syncthreads();
    (void)xcd_barrier_post((unsigned*)(p0.ws + WS_BAR), xst);
    int ph = 0; const int ph_lo_ = p0.ph_lo, ph_hi_ = p0.ph_hi;
#define PH_BEGIN if (ph >= ph_lo_ && ph < ph_hi_) { const Params p = load_params(); const int tid = launder_tid(), lane = tid & 63, wave = tid >> 6, bid = launder_bid(), gw = wave * G + bid; (void)lane; (void)gw; unsigned char* ws = launder_ptr(p.ws); unsigned char* big = ws + WS_BIG; unsigned char* misc = ws + WS_MISC; bf16_t* hn = (bf16_t*)(ws + WS_HN); bf16_t* obuf = (bf16_t*)(ws + WS_O); float* outp = (float*)launder_ptr((unsigned char*)p.out); (void)big; (void)misc; (void)hn; (void)obuf; (void)outp;
#define EVP bf16_t* qkv = (bf16_t*)(big + EB_QKV); bf16_t* op = (bf16_t*)(big + EB_OP); float* lsep = (float*)(big + EB_LSE); (void)qkv; (void)op; (void)lsep;
#define PH_END   if (ph + 1 < ph_hi_) { if (p.ph_lo < 0) grid.sync(); XcdBarrier xb_; xb_.bar = (unsigned*)(launder_ptr(p.ws) + WS_BAR); xb_.x = xb_xcc_id(); xb_.st = (volatile LAS unsigned*)(lds + LDS_XB); for (int rs_ = 0; rs_ < REP_SYNC; ++rs_) xcd_barrier(xb_); } } ++ph;

    for (int layer = 0; layer < 4; ++layer) {
        const int li = layer >> 1; const bool odd = layer & 1;

        PH_BEGIN for (int rep = 0; rep < REP_MISC; ++rep) { phase_convert(p, layer, lds); phase_rmsnorm(layer == 0 ? p.x : outp, p.norm_mix + layer * DM, hn, nullptr); } PH_END
        if (!odd) {
            PH_BEGIN { EVP pg8::Gemm g{hn, (const bf16_t*)(ws + WS_WIN), M_, 2304, 1024}; pg8::StaticOrder so; so.init(M_, 2304, G, bid); EpiBf16 e{qkv, 2304};
                for (int rep = 0; rep < REP_GEIN; ++rep) pg8::gemm_phase<EpiBf16, pg8::StaticOrder, true, true>(lds, g, so, e); } PH_END
            PH_BEGIN { EVP
                for (int rep = 0; rep < REP_EATT; ++rep) for (int j = (G == 256 ? (bid >> 3) * 8 + wave : gw); j < (G == 256 ? 8192 : 65536); j += (G == 256 ? 256 : nw)) {
                    const int kind = G == 256 ? j >> 11 : j >> 14, b = G == 256 ? (j >> 10) & 1 : (j >> 13) & 1, h = G == 256 ? (bid & 7) : (j >> 10) & 7, tile = j & 1023;
                    const bf16_t* base = qkv + (size_t)b * S_ * 2304;
                    if (kind == 0) {
                        band_unit<false>(base + h * 64, 2304, base + 512 + (h >> 2) * 64, 2304, base + 640 + (h >> 2) * 64, 2304, S_, 1, 0, 127, h, tile * 16,
                                         obuf + (size_t)b * S_ * 1024 + h * 64, 1024, nullptr, 0, nullptr, 0, true, p.even_sinks[li * 8 + h], tbl, lane);
                    } else {
                        const int sh = 2 * (kind - 1), dil = 1 << sh, L = S_ >> sh; const int res = tile >> (10 - sh), it = tile & ((1024 >> sh) - 1);
                        band_unit<false>(base + 768 + h * 64, 2304, base + 1280 + h * 64, 2304, base + 1792 + h * 64, 2304, L, dil, res, 128, 8 + h, it * 16,
                                         op + ((size_t)(kind - 1) * M_ + (size_t)b * S_) * 512 + h * 64, 512, lsep + ((size_t)(kind - 1) * M_ + (size_t)b * S_) * 8 + h, 8, nullptr, 0, false, 0.f, tbl, lane);
                    }
                }
            } PH_END
            PH_BEGIN { EVP
                for (int u = bid * 512 + tid; u < M_ * 8 * 8; u += G * 512) {
                    const int tok = u >> 6, h = (u >> 3) & 7, ch = u & 7;
                    const float l0 = lsep[(size_t)tok * 8 + h], l1 = lsep[((size_t)M_ + tok) * 8 + h], l2 = lsep[((size_t)2 * M_ + tok) * 8 + h];
                    const float mx = fmaxf(l0, fmaxf(l1, l2)); float w0 = __expf(l0 - mx), w1 = __expf(l1 - mx), w2 = __expf(l2 - mx); const float iw = 1.0f / (w0 + w1 + w2); w0 *= iw; w1 *= iw; w2 *= iw;
                    const size_t eo = (size_t)tok * 512 + h * 64 + ch * 8;
                    const u32x4 a = *(const u32x4*)(op + eo), b4 = *(const u32x4*)(op + (size_t)M_ * 512 + eo), c4 = *(const u32x4*)(op + (size_t)2 * M_ * 512 + eo);
                    u32x4 r;
#pragma unroll
                    for (int k = 0; k < 4; ++k) r[k] = pk2(w0 * bflo(a[k]) + w1 * bflo(b4[k]) + w2 * bflo(c4[k]), w0 * bfhi(a[k]) + w1 * bfhi(b4[k]) + w2 * bfhi(c4[k]));
                    *(u32x4*)(obuf + (size_t)tok * 1024 + 512 + h * 64 + ch * 8) = r;
                }
            } PH_END
            PH_BEGIN { pg8::Gemm g{obuf, (const bf16_t*)(ws + WS_WOUT), M_, 1024, 1024}; pg8::StaticOrder so; so.init(M_, 1024, G, bid); for (int rep = 0; rep < REP_GRES; ++rep) { EpiResid e{layer == 0 ? p.x : outp, outp, REAL_(rep, REP_GRES)};
                pg8::gemm_phase<EpiResid, pg8::StaticOrder, true, true>(lds, g, so, e); } } PH_END
        } else {
            for (int b = 0; b < 2; ++b) {
                PH_BEGIN { pg8::Gemm g{hn + (size_t)b * S_ * 1024, (const bf16_t*)(ws + WS_WIN), S_, 8192, 1024}; pg8::StaticOrder so; so.init(S_, 8192, G, bid); EpiOddIn e{big};
                    for (int rep = 0; rep < REP_GIN; ++rep) pg8::gemm_phase<EpiOddIn, pg8::StaticOrder, true, true>(lds, g, so, e); } PH_END
                PH_BEGIN {
                    { const int ln = launder_tid() & 63; for (int rep = 0; rep < REP_CHAIN; ++rep) for (int hc = bid; hc < 256; hc += G) for (int k = 0; k < 2; ++k) u_unit(big, hn, hc >> 6, hc & 63, wave + 16 * k, ln); }
                    { const int ln = launder_tid() & 63; for (int u = gw; u < 256; u += nw) compress_unit(ws, big, misc, (u & 63) * 16, (u >> 6) & 1, u >> 7, ln); }
                    { const int ln = launder_tid() & 63; for (int rep = 0; rep < REP_WIN; ++rep) {
                        if (G == 256) { const int lw = (bid >> 3) * 8 + wave, tile = (bid & 7) * 128 + (lw & 127);
                            for (int h = lw >> 7; h < 16; h += 2) win_unit(big, obuf, h, tile * 16, tbl, ln); }
                        else for (int v = gw; v < 16384; v += nw) win_unit(big, obuf, v >> 10, (v & 1023) * 16, tbl, ln); } }
                } PH_END
                PH_BEGIN {
                    { const int ln = launder_tid() & 63; scan_items(hn, gw, nw, ln); }
                    { const int tl = launder_tid(); const int ln = tl & 63, wv = __builtin_amdgcn_readfirstlane(tl >> 6);
                      for (int rep = 0; rep < REP_CMP; ++rep) for (int ts = bid; ts < 256; ts += G)
                        for (int i = 0; i < 8; ++i) { const int q = i >> 1, grp = i & 1; const int tile = q == 0 ? ts : (q == 1 ? 511 - ts : (q == 2 ? 512 + ts : 1023 - ts));
                            cmp_unit(big, misc, (int*)(misc + MS_IDX), obuf, tile * 16, grp, tbl, (LAS float*)lds, wv, ln, REAL_(rep, REP_CMP)); } }
                } PH_END
                PH_BEGIN {
                    { const int ln = launder_tid() & 63; for (int rep = 0; rep < REP_INTRA; ++rep) for (int hc = bid; hc < 256; hc += G) for (int k = 0; k < 2; ++k) { const int tl = k ? 15 - wave : wave;
                            intra_unit(big, hn, obuf, p.odd_ret_gn + (size_t)li * 2048, hc >> 6, ((hc & 63) * 16 + tl) * 16, ln, REAL_(rep, REP_INTRA)); } }
                    { const int ln = launder_tid() & 63; for (int rep = 0; rep < REP_SEL; ++rep) {
                        if (G == 256) { const int grp = bid & 1, xq = (bid >> 1) & 3, lw = (bid >> 3) * 8 + wave;
                            for (int t = xq * 4096 + lw; t < (xq + 1) * 4096; t += 256) sel_unit(big, (const int*)(misc + MS_IDX), obuf, t, grp, tbl, ln, REAL_(rep, REP_SEL)); }
                        else for (int u = gw; u < 2 * S_; u += nw) sel_unit(big, (const int*)(misc + MS_IDX), obuf, u >> 1, u & 1, tbl, ln, REAL_(rep, REP_SEL)); } }
                } PH_END
                PH_BEGIN { pg8::Gemm g{obuf, (const bf16_t*)(ws + WS_WOUT), S_, 1024, 3072}; pg8::StaticOrder so; so.init(S_, 1024, G, bid);
                    for (int rep = 0; rep < REP_GRES; ++rep) { EpiResid e{(layer == 0 ? p.x : outp) + (size_t)b * S_ * 1024, outp + (size_t)b * S_ * 1024, REAL_(rep, REP_GRES)};
                    pg8::gemm_phase<EpiResid, pg8::StaticOrder, true, true>(lds, g, so, e); }
                    if (b == 0) phase_rmsnorm(outp, p.norm_mix + layer * DM, hn, nullptr, S_, M_);
                } PH_END
            }
        }
        PH_BEGIN phase_rmsnorm(outp, p.norm_ffn + layer * DM, hn, nullptr); PH_END
        PH_BEGIN { pg8::Gemm g{hn, (const bf16_t*)(ws + WS_WGU), M_, 5632, 1024}; pg8::StaticOrder so; so.init(M_, 5632, G, bid); EpiSwiglu e{(bf16_t*)big};
            for (int rep = 0; rep < REP_GGU; ++rep) pg8::gemm_phase<EpiSwiglu, pg8::StaticOrder, true, true>(lds, g, so, e); } PH_END
        PH_BEGIN { pg8::Gemm g{(const bf16_t*)big, (const bf16_t*)(ws + WS_WDN), M_, 1024, FF_}; pg8::StaticOrder so; so.init(M_, 1024, G, bid); for (int rep = 0; rep < REP_GRES; ++rep) { EpiResid e{outp, outp, REAL_(rep, REP_GRES)};
            pg8::gemm_phase<EpiResid, pg8::StaticOrder, true, true>(lds, g, so, e); } } PH_END
    }
    PH_BEGIN phase_rmsnorm(outp, p.norm_final, nullptr, outp); PH_END
}

#ifndef N_PHASES
#define N_PHASES 45
#endif
#ifndef ONE_LAUNCH
#define ONE_LAUNCH 1
#endif
extern "C" void kernel_launch(void* const* d_in, const int* in_sizes, int n_in, void* d_out, int out_size, void* d_ws, size_t ws_size, hipStream_t stream) {
    static int grid = 0;
    if (grid == 0) {
        if (n_in != 20 || out_size != M_ * DM || ws_size < WS_END) { fprintf(stderr, "kernel_launch: unexpected shapes (n_in %d, out %d, ws %zu); nothing launched\n", n_in, out_size, ws_size); grid = -1; return; }
        int dev = 0, cus = 0;
        if (hipGetDevice(&dev) != hipSuccess || hipDeviceGetAttribute(&cus, hipDeviceAttributeMultiprocessorCount, dev) != hipSuccess) { grid = -1; return; }
        if (hipFuncSetAttribute((const void*)trunk_fwd, hipFuncAttributeMaxDynamicSharedMemorySize, LDS_BYTES) != hipSuccess) { fprintf(stderr, "kernel_launch: hipFuncSetAttribute failed\n"); grid = -1; return; }
        int per_cu = 0;
        if (hipOccupancyMaxActiveBlocksPerMultiprocessor(&per_cu, (const void*)trunk_fwd, 512, LDS_BYTES) != hipSuccess || per_cu < 1) { fprintf(stderr, "kernel_launch: occupancy query says %d\n", per_cu); (void)hipGetLastError(); }
        grid = cus;
    }
    if (grid < 0) return;
    Params p{};
    const float** pp = (const float**)&p;
    for (int i = 0; i < 20; ++i) pp[i] = (const float*)d_in[i];
    p.out = (float*)d_out; p.ws = (unsigned char*)d_ws;
#if ONE_LAUNCH
    p.ph_lo = 0; p.ph_hi = N_PHASES;
    if (hipMemsetAsync((unsigned char*)d_ws + WS_BAR, 0, XCD_BAR_WORDS * 4, stream) != hipSuccess) { fprintf(stderr, "kernel_launch: memset of the barrier words failed\n"); return; }
    void* args[] = {&p};
    hipError_t e = hipLaunchCooperativeKernel((const void*)trunk_fwd, dim3(grid), dim3(512), args, LDS_BYTES, stream);
    if (e != hipSuccess) fprintf(stderr, "kernel_launch: cooperative launch failed: %s (grid %d)\n", hipGetErrorString(e), grid);
#else
    for (int ph = 0; ph < N_PHASES; ++ph) { p.ph_lo = ph; p.ph_hi = ph + 1; hipLaunchKernelGGL(trunk_fwd, dim3(grid), dim3(512), LDS_BYTES, stream, p); }
#endif
}
```
